# Optimizing an MI355X kernel written in HIP

```python
import math
import jax, jax.numpy as jnp
from jax import lax
import numpy as np

D_MODEL = 2048
BATCH = 16
SEQ = 256
DEPTH = 4
DEC_BATCH = 4
DEC_SEQ = 2048
PAST_LEN = 512

GRID_W = 64
HEAD_DIM = 128
Q_BLOCK = 128
EPS = 1e-6
ROPE_THETA = 10000.0
DA_HEADS = 4
DA_DH = HEAD_DIM // 2
LRU_WIDTH = 512
LRU_BLOCKS = 4
LRU_BS = LRU_WIDTH // LRU_BLOCKS
LRU_C = 8.0
CONV_W = 4
CONV_LEFT = 2
NA_HEADS = 4
NA_ROWS = 8
NA_COLS = 16
GQA_Q_HEADS = 4
GQA_KV_HEADS = 2
IN_SPLITS = (DA_HEADS * HEAD_DIM, DA_HEADS * HEAD_DIM, DA_HEADS * HEAD_DIM,
             LRU_WIDTH, LRU_WIDTH,
             NA_HEADS * HEAD_DIM, NA_HEADS * HEAD_DIM, NA_HEADS * HEAD_DIM,
             GQA_Q_HEADS * HEAD_DIM, GQA_KV_HEADS * HEAD_DIM, GQA_KV_HEADS * HEAD_DIM)
IN_WIDTH = sum(IN_SPLITS)
MIX_WIDTH = DA_HEADS * HEAD_DIM + LRU_WIDTH + NA_HEADS * HEAD_DIM + GQA_Q_HEADS * HEAD_DIM
FFN_HIDDEN = ((8 * D_MODEL // 3 + 255) // 256) * 256

kernel_name = "hybrid_diffusion_parallel_heads_step"


def rmsnorm(x, g=None):
    xf = x.astype(jnp.float32)
    y = xf * lax.rsqrt(jnp.mean(xf * xf, axis=-1, keepdims=True) + EPS)
    if g is not None:
        y = y * g.astype(jnp.float32)
    return y.astype(x.dtype)


def axial_rope(x):
    n = x.shape[1]
    m = x.shape[-1] // 2
    t = jnp.arange(n)
    freqs = ROPE_THETA ** (-jnp.arange(0, m, 2, dtype=jnp.float32) / m)
    bshape = (n,) + (1,) * (x.ndim - 3) + (m // 2,)

    def rot(xh, pos):
        ang = (pos.astype(jnp.float32)[:, None] * freqs).reshape(bshape)
        cos = jnp.cos(ang).astype(x.dtype)
        sin = jnp.sin(ang).astype(x.dtype)
        x1, x2 = jnp.split(xh, 2, axis=-1)
        return jnp.concatenate([x1 * cos - x2 * sin, x1 * sin + x2 * cos], axis=-1)

    return jnp.concatenate([rot(x[..., :m], t // GRID_W), rot(x[..., m:], t % GRID_W)], axis=-1)


def sweep_query_blocks(fn, q):
    b, sq = q.shape[:2]
    nb = sq // Q_BLOCK
    qb = jnp.moveaxis(q.reshape((b, nb, Q_BLOCK) + q.shape[2:]), 1, 0)
    out = jnp.moveaxis(lax.map(fn, qb), 0, 1)
    return out.reshape((b, sq) + out.shape[3:])


def diff_attention(q, k, v, lam, lam_init):
    scale = DA_DH ** -0.5

    def block(qb):
        s = jnp.einsum('bqhcd,bkhcd->bhcqk', qb, k).astype(jnp.float32) * scale
        p = jax.nn.softmax(s, axis=-1)
        p = p[:, :, 0] - lam * p[:, :, 1]
        return jnp.einsum('bhqk,bkhd->bqhd', p.astype(v.dtype), v)

    o = sweep_query_blocks(block, q)
    return rmsnorm(o) * (1.0 - lam_init)


def gqa_attention(q, k, v):
    b, sq, hq, d = q.shape
    hkv = k.shape[2]
    qg = q.reshape(b, sq, hkv, hq // hkv, d)
    scale = d ** -0.5

    def block(qb):
        s = jnp.einsum('bqngd,bsnd->bngqs', qb, k).astype(jnp.float32) * scale
        p = jax.nn.softmax(s, axis=-1).astype(v.dtype)
        return jnp.einsum('bngqs,bsnd->bqngd', p, v)

    return sweep_query_blocks(block, qg).reshape(b, sq, hq, d)


def neighbourhood_attention(q, k, v, k_ctx, v_ctx, rpb):
    b, n, h, d = q.shape
    rows = n // GRID_W
    kr = min(NA_ROWS, rows)
    scale = d ** -0.5
    qg = q.reshape(b, rows, GRID_W, h, d)
    kg = k.reshape(b, rows, GRID_W, h, d)
    vg = v.reshape(b, rows, GRID_W, h, d)
    w_idx = np.arange(GRID_W)
    col_start = np.clip(w_idx - NA_COLS // 2, 0, GRID_W - NA_COLS)
    col_idx = col_start[:, None] + np.arange(NA_COLS)[None, :]
    rpb_cols = rpb[:, :, col_idx - w_idx[:, None] + NA_COLS - 1]
    n_loc = kr * NA_COLS

    def row_block(args):
        r, qr = args
        start = jnp.clip(r - kr // 2, 0, rows - kr)
        kw = lax.dynamic_slice_in_dim(kg, start, kr, axis=1)[:, :, col_idx]
        vw = lax.dynamic_slice_in_dim(vg, start, kr, axis=1)[:, :, col_idx]
        s_loc = jnp.einsum('bwhd,biwjhd->bhwij', qr, kw).astype(jnp.float32) * scale
        row_off = start + jnp.arange(kr) - r + NA_ROWS - 1
        bias = jnp.transpose(rpb_cols[:, row_off], (0, 2, 1, 3)).astype(jnp.float32)
        s_loc = (s_loc + bias[None]).reshape(b, h, GRID_W, n_loc)
        s_ctx = jnp.einsum('bwhd,bphd->bhwp', qr, k_ctx).astype(jnp.float32) * scale
        p = jax.nn.softmax(jnp.concatenate([s_loc, s_ctx], axis=-1), axis=-1).astype(v.dtype)
        p_loc = p[..., :n_loc].reshape(b, h, GRID_W, kr, NA_COLS)
        return (jnp.einsum('bhwij,biwjhd->bwhd', p_loc, vw)
                + jnp.einsum('bhwp,bphd->bwhd', p[..., n_loc:], v_ctx))

    o = lax.map(row_block, (jnp.arange(rows), jnp.moveaxis(qg, 1, 0)))
    return jnp.moveaxis(o, 0, 1).reshape(b, n, h, d)


def centred_conv(x, w, bias):
    s = x.shape[1]
    xp = jnp.pad(x, ((0, 0), (CONV_LEFT, CONV_W - 1 - CONV_LEFT), (0, 0)))
    return bias + sum(xp[:, j:j + s] * w[j] for j in range(CONV_W))


def rglru_coeffs(x, gate_w, gate_b, lam_param):
    b, s, c = x.shape
    xb = x.reshape(b, s, LRU_BLOCKS, LRU_BS)
    gates = jnp.einsum('bsnc,gncd->gbsnd', xb, gate_w).reshape(2, b, s, c) + gate_b[:, None, None, :]
    r, i = jax.nn.sigmoid(gates.astype(jnp.float32))
    log_a = -LRU_C * r * jax.nn.softplus(-lam_param.astype(jnp.float32))
    a = jnp.exp(log_a)
    mult = jnp.sqrt(-jnp.expm1(2.0 * log_a))
    return a, mult * i * x.astype(jnp.float32)


def linear_scan(a, bx, h0, reverse):
    if reverse:
        a, bx = jnp.flip(a, 1), jnp.flip(bx, 1)
    bx = bx.at[:, 0].add(a[:, 0] * h0)

    def combine(e1, e2):
        a1, b1 = e1
        a2, b2 = e2
        return a1 * a2, a2 * b1 + b2

    _, h = lax.associative_scan(combine, (a, bx), axis=1)
    final = h[:, -1]
    if reverse:
        h = jnp.flip(h, 1)
    return h, final


def rglru_bidir(xb, gb, conv_w, conv_b, gate_w, gate_b, lam_param, h0):
    xc = centred_conv(xb, conv_w, conv_b)
    a_f, b_f = rglru_coeffs(xc, gate_w[0], gate_b[0], lam_param[0])
    h_f, fin_f = linear_scan(a_f, b_f, h0[:, 0].astype(jnp.float32), False)
    a_b, b_b = rglru_coeffs(xc, gate_w[1], gate_b[1], lam_param[1])
    h_b, fin_b = linear_scan(a_b, b_b, h0[:, 1].astype(jnp.float32), True)
    y = (h_f + h_b).astype(xb.dtype) * jax.nn.gelu(gb)
    return y, jnp.stack([fin_f, fin_b], axis=1).astype(xb.dtype)


def split_in(u):
    return jnp.split(u, np.cumsum(IN_SPLITS)[:-1].tolist(), axis=-1)


def setup_inputs(seed: int = 0) -> dict:
    key = jax.random.key(seed)
    ks = jax.random.split(key, 24)

    def nrm(k, shape, scale):
        return scale * jax.random.normal(k, shape, jnp.float32)

    u = jax.random.uniform(ks[17], (DEPTH, 2, LRU_WIDTH), jnp.float32, 0.9, 0.999)
    s = u ** (1.0 / LRU_C)
    lru_lambda = jnp.log(s) - jnp.log1p(-s)
    return {
        "x_prompt": nrm(ks[0], (BATCH, SEQ, D_MODEL), 1.0),
        "x_sample": nrm(ks[1], (DEC_BATCH, DEC_SEQ, D_MODEL), 1.0),
        "cache_diff_kv": nrm(ks[2], (DEC_BATCH, DEPTH, 2, PAST_LEN, DA_HEADS, HEAD_DIM), 1.0),
        "state_rglru": nrm(ks[3], (DEC_BATCH, DEPTH, 2, LRU_WIDTH), 0.5),
        "cache_na_kv": nrm(ks[4], (DEC_BATCH, DEPTH, 2, PAST_LEN, NA_HEADS, HEAD_DIM), 1.0),
        "cache_gqa_kv": nrm(ks[5], (DEC_BATCH, DEPTH, 2, PAST_LEN, GQA_KV_HEADS, HEAD_DIM), 1.0),
        "c": nrm(ks[6], (DEC_BATCH, D_MODEL), 1.0),
        "c_ctx": nrm(ks[7], (D_MODEL,), 1.0),
        "w_mod": nrm(ks[8], (DEPTH, D_MODEL, 6 * D_MODEL), 0.5 * D_MODEL ** -0.5),
        "b_mod": nrm(ks[9], (DEPTH, 6 * D_MODEL), 0.01),
        "norm_g": 1.0 + nrm(ks[10], (DEPTH, 4, D_MODEL), 0.05),
        "w_in": nrm(ks[11], (DEPTH, D_MODEL, IN_WIDTH), D_MODEL ** -0.5),
        "diff_lambda_w": nrm(ks[12], (DEPTH, 4, DA_DH), 0.1),
        "lru_conv_w": nrm(ks[13], (DEPTH, CONV_W, LRU_WIDTH), CONV_W ** -0.5),
        "lru_conv_b": nrm(ks[14], (DEPTH, LRU_WIDTH), 0.01),
        "lru_gate_w": nrm(ks[15], (DEPTH, 2, 2, LRU_BLOCKS, LRU_BS, LRU_BS), LRU_BS ** -0.5),
        "lru_gate_b": nrm(ks[16], (DEPTH, 2, 2, LRU_WIDTH), 0.01),
        "lru_lambda": lru_lambda,
        "na_rpb": nrm(ks[18], (DEPTH, NA_HEADS, 2 * NA_ROWS - 1, 2 * NA_COLS - 1), 0.1),
        "gqa_qk_g": 1.0 + nrm(ks[19], (DEPTH, 2, HEAD_DIM), 0.05),
        "w_out": nrm(ks[20], (DEPTH, MIX_WIDTH, D_MODEL), MIX_WIDTH ** -0.5),
        "w_ffn_in": nrm(ks[21], (DEPTH, D_MODEL, 2 * FFN_HIDDEN), D_MODEL ** -0.5),
        "w_ffn_out": nrm(ks[22], (DEPTH, FFN_HIDDEN, D_MODEL), FFN_HIDDEN ** -0.5),
    }


def reference(x_prompt, x_sample, cache_diff_kv, state_rglru, cache_na_kv, cache_gqa_kv,
              c, c_ctx, w_mod, b_mod, norm_g, w_in, diff_lambda_w, lru_conv_w, lru_conv_b,
              lru_gate_w, lru_gate_b, lru_lambda, na_rpb, gqa_qk_g, w_out, w_ffn_in, w_ffn_out):

    def diff_lambda(l):
        lq1, lk1, lq2, lk2 = diff_lambda_w[l].astype(jnp.float32)
        lam_init = 0.8 - 0.6 * math.exp(-0.3 * l)
        lam = jnp.exp(jnp.sum(lq1 * lk1)) - jnp.exp(jnp.sum(lq2 * lk2)) + lam_init
        return lam, lam_init

    def rglru(xb, gb, l, h0):
        return rglru_bidir(xb, gb, lru_conv_w[l], lru_conv_b[l], lru_gate_w[l], lru_gate_b[l],
                           lru_lambda[l], h0)

    def context_mixer(u, l):
        b, s = u.shape[:2]
        aq, ak, av, bx, bg, cq, ck, cv, dq, dk, dv = split_in(u)
        lam, lam_init = diff_lambda(l)
        va = av.reshape(b, s, DA_HEADS, HEAD_DIM)
        o_a = diff_attention(aq.reshape(b, s, DA_HEADS, 2, DA_DH), ak.reshape(b, s, DA_HEADS, 2, DA_DH),
                             va, lam, lam_init)
        kv_a = jnp.stack([ak.reshape(b, s, DA_HEADS, HEAD_DIM), va], axis=1)
        o_b, st_b = rglru(bx, bg, l, jnp.zeros((b, 2, LRU_WIDTH), jnp.float32))
        kc = ck.reshape(b, s, NA_HEADS, HEAD_DIM)
        vc = cv.reshape(b, s, NA_HEADS, HEAD_DIM)
        o_c = gqa_attention(cq.reshape(b, s, NA_HEADS, HEAD_DIM), kc, vc)
        kv_c = jnp.stack([kc, vc], axis=1)
        qd = rmsnorm(dq.reshape(b, s, GQA_Q_HEADS, HEAD_DIM), gqa_qk_g[l, 0])
        kd = rmsnorm(dk.reshape(b, s, GQA_KV_HEADS, HEAD_DIM), gqa_qk_g[l, 1])
        vd = dv.reshape(b, s, GQA_KV_HEADS, HEAD_DIM)
        o_d = gqa_attention(qd, kd, vd)
        kv_d = jnp.stack([kd, vd], axis=1)
        out = jnp.concatenate([o_a.reshape(b, s, -1), o_b, o_c.reshape(b, s, -1), o_d.reshape(b, s, -1)],
                              axis=-1)
        return out, (kv_a, st_b, kv_c, kv_d)

    def latent_mixer(u, l):
        b, n = u.shape[:2]
        p = cache_diff_kv.shape[3]
        aq, ak, av, bx, bg, cq, ck, cv, dq, dk, dv = split_in(u)
        lam, lam_init = diff_lambda(l)
        qa = axial_rope(aq.reshape(b, n, DA_HEADS, 2, DA_DH))
        ka = axial_rope(ak.reshape(b, n, DA_HEADS, 2, DA_DH))
        ka = jnp.concatenate([cache_diff_kv[:, l, 0].reshape(b, p, DA_HEADS, 2, DA_DH), ka], axis=1)
        va = jnp.concatenate([cache_diff_kv[:, l, 1], av.reshape(b, n, DA_HEADS, HEAD_DIM)], axis=1)
        o_a = diff_attention(qa, ka, va, lam, lam_init)
        o_b, _ = rglru(bx, bg, l, state_rglru[:, l])
        o_c = neighbourhood_attention(cq.reshape(b, n, NA_HEADS, HEAD_DIM), ck.reshape(b, n, NA_HEADS, HEAD_DIM),
                                      cv.reshape(b, n, NA_HEADS, HEAD_DIM),
                                      cache_na_kv[:, l, 0], cache_na_kv[:, l, 1], na_rpb[l])
        qd = axial_rope(rmsnorm(dq.reshape(b, n, GQA_Q_HEADS, HEAD_DIM), gqa_qk_g[l, 0]))
        kd = axial_rope(rmsnorm(dk.reshape(b, n, GQA_KV_HEADS, HEAD_DIM), gqa_qk_g[l, 1]))
        kd = jnp.concatenate([cache_gqa_kv[:, l, 0], kd], axis=1)
        vd = jnp.concatenate([cache_gqa_kv[:, l, 1], dv.reshape(b, n, GQA_KV_HEADS, HEAD_DIM)], axis=1)
        o_d = gqa_attention(qd, kd, vd)
        out = jnp.concatenate([o_a.reshape(b, n, -1), o_b, o_c.reshape(b, n, -1), o_d.reshape(b, n, -1)],
                              axis=-1)
        return out, None

    def layer(x, cond, l, mixer):
        mod = (jax.nn.silu(cond) @ w_mod[l] + b_mod[l])[:, None, :]
        sh_m, sc_m, g_m, sh_f, sc_f, g_f = jnp.split(mod, 6, axis=-1)
        h = rmsnorm(x, norm_g[l, 0]) * (1.0 + sc_m) + sh_m
        m, ctx_out = mixer(h @ w_in[l], l)
        x = x + g_m * rmsnorm(m @ w_out[l], norm_g[l, 1])
        h = rmsnorm(x, norm_g[l, 2]) * (1.0 + sc_f) + sh_f
        a, g = jnp.split(h @ w_ffn_in[l], 2, axis=-1)
        x = x + g_f * rmsnorm((jax.nn.silu(g) * a) @ w_ffn_out[l], norm_g[l, 3])
        return x, ctx_out

    y_prompt = x_prompt
    kv_a_list, st_list, kv_c_list, kv_d_list = [], [], [], []
    for l in range(DEPTH):
        y_prompt, (kv_a, st_b, kv_c, kv_d) = layer(y_prompt, c_ctx[None, :], l, context_mixer)
        kv_a_list.append(kv_a)
        st_list.append(st_b)
        kv_c_list.append(kv_c)
        kv_d_list.append(kv_d)
    new_cache_diff_kv = jnp.stack(kv_a_list, axis=1)
    new_state_rglru = jnp.stack(st_list, axis=1)
    new_cache_na_kv = jnp.stack(kv_c_list, axis=1)
    new_cache_gqa_kv = jnp.stack(kv_d_list, axis=1)

    y_sample = x_sample
    for l in range(DEPTH):
        y_sample, _ = layer(y_sample, c, l, latent_mixer)

    return (y_prompt, y_sample, new_cache_diff_kv, new_state_rglru, new_cache_na_kv, new_cache_gqa_kv)
```

```cpp
#include <hip/hip_runtime.h>
#include <cstdio>
#include <cstdint>
namespace pg8 {
#define PG8_LAS __attribute__((address_space(3)))
typedef unsigned short bf16_t;
typedef short bf16x8 __attribute__((ext_vector_type(8)));
typedef float f32x4 __attribute__((ext_vector_type(4)));
typedef unsigned u32x4 __attribute__((ext_vector_type(4)));
constexpr int BM = 256, BK = 64, HALF = 128, HTB = HALF * BK * 2  , STAGE_BYTES = 8 * HTB, NXCD = 8, WGM = 8;

__host__ __device__ __forceinline__ int lds_byte(int r, int c) { const int st = (r >> 4) * 2 + (c >> 5), rr = r & 15, cc = c & 31, ob = rr * 64 + cc * 2; return st * 1024 + (ob ^ (((ob >> 9) & 1) << 5)); }
__host__ __device__ __forceinline__ void stage_rc(int b, int& R, int& C) { const int st = b / 1024, sb = b % 1024, swz = sb ^ (((sb >> 9) & 1) << 5); R = (st >> 1) * 16 + swz / 64; C = (st & 1) * 32 + (swz % 64) / 2; }
__host__ __device__ __forceinline__ int perm32(int rho) { const int n = rho >> 4, i = rho & 15; return 8 * (i >> 2) + 4 * n + (i & 3); }

struct Unit { int pm, pn; };
struct Gemm { const bf16_t* A; const bf16_t* Bt; int M, N, K; };

struct StaticOrder {
    int nM, nN, nwg, G, c;
    __host__ __device__ void init(int M, int N, int G_, int c_) { nM = M / BM; nN = N / BM; nwg = nM * nN; G = G_; c = c_; }
    __host__ __device__ bool next(int i, Unit& u) const {
        const long L = (long)i * G + c; if (L >= nwg) return false;
        int wgid = (int)L; { const int q = nwg / NXCD, r = nwg % NXCD, xcd = wgid % NXCD, off = wgid / NXCD; wgid = (xcd < r ? xcd * (q + 1) : r * (q + 1) + (xcd - r) * q) + off; }
        const int nig = WGM * nN, gid = wgid / nig, fm = gid * WGM, gsz = (nM - fm) < WGM ? (nM - fm) : WGM;
        u.pm = fm + ((wgid % nig) % gsz); u.pn = (wgid % nig) / gsz; return true;
    }
    __device__ __forceinline__ void a_ready(const Unit&) const {}
    __device__ __forceinline__ void done(const Unit&) const {}
};

__device__ __forceinline__ unsigned cvt_pk_bf16(float lo, float hi) { unsigned r; asm volatile("v_cvt_pk_bf16_f32 %0, %1, %2" : "=v"(r) : "v"(lo), "v"(hi)); return r; }
typedef float f32x2 __attribute__((ext_vector_type(2)));
template <class Epi, class Sched, bool ALIGN_EPI = false, bool SP2 = false>
__device__ __forceinline__ void gemm_phase(PG8_LAS unsigned char* lds, const Gemm g, const Sched& S, const Epi& E) {
    int tid_ = threadIdx.x; asm volatile("" : "+v"(tid_));
    const int tid = tid_, wid = __builtin_amdgcn_readfirstlane(tid >> 6), lane = tid & 63, wr = wid >> 2, wc = wid & 3, fr = lane & 15, fq = lane >> 4;
    const int K = g.K, nt = K / BK;
    unsigned voffA[2], voffB[2];
#pragma unroll
    for (int i = 0; i < 2; ++i) { int R, C; stage_rc(tid * 16 + i * 8192, R, C); const int Rb = Epi::PERM ? ((R & ~31) + perm32(R & 31)) : R;
        voffA[i] = (unsigned)(R * K + C) * 2u; voffB[i] = (unsigned)(Rb * K + C) * 2u; }
    const size_t kstep = (size_t)(BK * 2);
    const size_t hstep = (size_t)HALF * K * 2;
    const size_t tstep = 2 * hstep;
    const unsigned ldsw = (unsigned)wid * 1024u;
    const int aoff = lds_byte(wr * 64 + fr, fq * 8), boff = lds_byte(wc * 32 + fr, fq * 8);
#define PG8_SA(b, h) (((b) * 2 + (h)) * HTB)
#define PG8_SB(b, h) ((4 + (b) * 2 + (h)) * HTB)
#define PG8_STAGE(bufoff, gbase, voff) do { _Pragma("unroll") for (int _i = 0; _i < 2; ++_i) \
        __builtin_amdgcn_global_load_lds((const unsigned*)((const char*)(gbase) + (voff)[_i]), (PG8_LAS unsigned*)(lds + (bufoff) + ldsw + _i * 8192), 16, 0, 0); } while (0)
#define PG8_LDA(dst, b, h) do { _Pragma("unroll") for (int m = 0; m < 4; ++m) _Pragma("unroll") for (int k = 0; k < 2; ++k) dst[m][k] = *(const PG8_LAS bf16x8*)(lds + PG8_SA(b, h) + aoff + m * 2048 + k * 1024); } while (0)
#define PG8_LDB(dst, b, h) do { _Pragma("unroll") for (int n = 0; n < 2; ++n) _Pragma("unroll") for (int k = 0; k < 2; ++k) dst[n][k] = *(const PG8_LAS bf16x8*)(lds + PG8_SB(b, h) + boff + n * 2048 + k * 1024); } while (0)
#define PG8_MMA(ai, bj, At, Bt) do { __builtin_amdgcn_s_setprio(1); _Pragma("unroll") for (int m = 0; m < 4; ++m) _Pragma("unroll") for (int n = 0; n < 2; ++n) _Pragma("unroll") for (int k = 0; k < 2; ++k) \
        acc[ai][bj][m][n] = __builtin_amdgcn_mfma_f32_16x16x32_bf16(Bt[n][k], At[m][k], acc[ai][bj][m][n], 0, 0, 0); __builtin_amdgcn_s_setprio(0); } while (0)
#define PG8_WAIT_V(n) asm volatile("s_waitcnt vmcnt(" #n ")" ::: "memory")
#define PG8_WAIT_L(n) asm volatile("s_waitcnt lgkmcnt(" #n ")" ::: "memory")
#define PG8_BAR __builtin_amdgcn_s_barrier()
#define PG8_SCHED __builtin_amdgcn_sched_barrier(0)
    Unit cur, nxt; int ui = 0;
    if (!S.next(0, cur)) return;
    f32x4 acc[2][2][4][2];
#pragma unroll
    for (int a = 0; a < 2; ++a)
#pragma unroll
        for (int b = 0; b < 2; ++b)
#pragma unroll
            for (int m = 0; m < 4; ++m)
#pragma unroll
                for (int n = 0; n < 2; ++n) acc[a][b][m][n] = (f32x4){0.f, 0.f, 0.f, 0.f};
    bf16x8 At[4][2], B0[2][2], B1[2][2];
    const char* cA = (const char*)g.A + (size_t)cur.pm * tstep; const char* cB = (const char*)g.Bt + (size_t)cur.pn * tstep;
    S.a_ready(cur);
    if constexpr (SP2) {
        PG8_STAGE(PG8_SB(0, 0), cB, voffB); PG8_STAGE(PG8_SB(0, 1), cB + hstep, voffB); PG8_STAGE(PG8_SA(0, 0), cA, voffA); PG8_STAGE(PG8_SA(0, 1), cA + hstep, voffA);
        if (wr == 1) PG8_BAR;
        PG8_WAIT_V(2); PG8_BAR;
        PG8_STAGE(PG8_SB(1, 0), cB + kstep, voffB); PG8_STAGE(PG8_SA(1, 0), cA + kstep, voffA); PG8_STAGE(PG8_SB(1, 1), cB + hstep + kstep, voffB);
        PG8_WAIT_V(6); PG8_BAR;
    } else {
        PG8_STAGE(PG8_SB(0, 0), cB, voffB); PG8_STAGE(PG8_SA(0, 0), cA, voffA); PG8_STAGE(PG8_SB(0, 1), cB + hstep, voffB); PG8_STAGE(PG8_SA(0, 1), cA + hstep, voffA);
        if (wr == 1) PG8_BAR;
        PG8_WAIT_V(4); PG8_BAR;
        PG8_STAGE(PG8_SB(1, 0), cB + kstep, voffB); PG8_STAGE(PG8_SA(1, 0), cA + kstep, voffA); PG8_STAGE(PG8_SB(1, 1), cB + hstep + kstep, voffB);
        PG8_WAIT_V(6); PG8_BAR;
    }
    for (;;) {
        const bool has_next = S.next(ui + 1, nxt);
        const char* nA = has_next ? (const char*)g.A + (size_t)nxt.pm * tstep : cA; const char* nB = has_next ? (const char*)g.Bt + (size_t)nxt.pn * tstep : cB;
        for (int t = 0; t < nt; t += 2) {
            const bool last = (t == nt - 2);
            const char* a1 = cA + (size_t)(t + 1) * kstep;
            const char* a2 = last ? nA : cA + (size_t)(t + 2) * kstep; const char* b2 = last ? nB : cB + (size_t)(t + 2) * kstep;
            const char* a3 = a2 + kstep; const char* b3 = b2 + kstep;
            if (last && has_next) S.a_ready(nxt);
            if constexpr (SP2) {
            PG8_LDB(B0, 0, 0); PG8_LDB(B1, 0, 1); PG8_SCHED; PG8_LDA(At, 0, 0); PG8_STAGE(PG8_SA(1, 1), a1 + hstep, voffA);
            PG8_WAIT_V(8); PG8_WAIT_L(0); PG8_BAR; PG8_MMA(0, 0, At, B0); PG8_MMA(0, 1, At, B1); PG8_BAR; PG8_SCHED;
            PG8_LDA(At, 0, 1); PG8_STAGE(PG8_SB(0, 0), b2, voffB); PG8_STAGE(PG8_SB(0, 1), b2 + hstep, voffB); PG8_STAGE(PG8_SA(0, 0), a2, voffA);
            PG8_WAIT_V(8); PG8_WAIT_L(0); PG8_BAR; PG8_MMA(1, 0, At, B0); PG8_MMA(1, 1, At, B1); PG8_BAR; PG8_SCHED;
            PG8_LDB(B0, 1, 0); PG8_LDB(B1, 1, 1); PG8_SCHED; PG8_LDA(At, 1, 0); PG8_STAGE(PG8_SA(0, 1), a2 + hstep, voffA);
            PG8_WAIT_V(8); PG8_WAIT_L(0); PG8_BAR; PG8_MMA(0, 0, At, B0); PG8_MMA(0, 1, At, B1); PG8_BAR; PG8_SCHED;
            PG8_LDA(At, 1, 1); PG8_STAGE(PG8_SB(1, 0), b3, voffB); PG8_STAGE(PG8_SB(1, 1), b3 + hstep, voffB); PG8_STAGE(PG8_SA(1, 0), a3, voffA);
            PG8_WAIT_V(8); PG8_WAIT_L(0); PG8_BAR; PG8_MMA(1, 0, At, B0); PG8_MMA(1, 1, At, B1); PG8_BAR; PG8_SCHED;
            } else {
            PG8_LDB(B0, 0, 0); PG8_SCHED; PG8_LDA(At, 0, 0); PG8_STAGE(PG8_SA(1, 1), a1 + hstep, voffA);
            PG8_WAIT_L(8); PG8_BAR; PG8_WAIT_L(0); PG8_MMA(0, 0, At, B0); PG8_BAR; PG8_SCHED;
            PG8_LDB(B1, 0, 1); PG8_STAGE(PG8_SB(0, 0), b2, voffB);
            PG8_BAR; PG8_WAIT_L(0); PG8_MMA(0, 1, At, B1); PG8_BAR;
            PG8_LDA(At, 0, 1); PG8_STAGE(PG8_SA(0, 0), a2, voffA);
            PG8_BAR; PG8_WAIT_L(0); PG8_MMA(1, 0, At, B0); PG8_BAR; PG8_SCHED;
            PG8_STAGE(PG8_SB(0, 1), b2 + hstep, voffB);
            PG8_WAIT_V(6); PG8_BAR; PG8_MMA(1, 1, At, B1); PG8_BAR;
            PG8_LDB(B0, 1, 0); PG8_SCHED; PG8_LDA(At, 1, 0); PG8_STAGE(PG8_SA(0, 1), a2 + hstep, voffA);
            PG8_WAIT_L(8); PG8_BAR; PG8_WAIT_L(0); PG8_MMA(0, 0, At, B0); PG8_BAR; PG8_SCHED;
            PG8_LDB(B1, 1, 1); PG8_STAGE(PG8_SB(1, 0), b3, voffB);
            PG8_BAR; PG8_WAIT_L(0); PG8_MMA(0, 1, At, B1); PG8_BAR;
            PG8_LDA(At, 1, 1); PG8_STAGE(PG8_SA(1, 0), a3, voffA);
            PG8_BAR; PG8_WAIT_L(0); PG8_MMA(1, 0, At, B0); PG8_BAR; PG8_SCHED;
            PG8_STAGE(PG8_SB(1, 1), b3 + hstep, voffB);
            PG8_WAIT_V(6); PG8_BAR; PG8_MMA(1, 1, At, B1); PG8_BAR;
            }
        }
        if constexpr (ALIGN_EPI) { if (wr == 0) PG8_BAR; }
        if constexpr (!Epi::AFTER_DRAIN) { E(acc, cur, wr, wc, fr, fq); S.done(cur); }
        if (!has_next) break;
#pragma unroll
        for (int a = 0; a < 2; ++a)
#pragma unroll
            for (int b = 0; b < 2; ++b)
#pragma unroll
                for (int m = 0; m < 4; ++m)
#pragma unroll
                    for (int n = 0; n < 2; ++n) acc[a][b][m][n] = (f32x4){0.f, 0.f, 0.f, 0.f};
        cur = nxt; cA = nA; cB = nB; ++ui;
        if constexpr (ALIGN_EPI) { if (wr == 1) PG8_BAR; }
    }
    PG8_WAIT_V(0);
    if constexpr (!ALIGN_EPI) { if (wr == 0) PG8_BAR; }
    PG8_BAR;
    if constexpr (Epi::AFTER_DRAIN) { E.fused(acc, cur, wr, wc, fr, fq, lds, wid, lane); S.done(cur); }
#undef PG8_SA
#undef PG8_SB
#undef PG8_STAGE
#undef PG8_LDA
#undef PG8_LDB
#undef PG8_MMA
#undef PG8_WAIT_V
#undef PG8_WAIT_L
#undef PG8_BAR
#undef PG8_SCHED
}
}
namespace mk {
using pg8::f32x4; using pg8::bf16x8; using pg8::u32x4; using pg8::Unit;
#define GAS __attribute__((address_space(1)))
#define LAS __attribute__((address_space(3)))
typedef unsigned short bf16;
typedef float f32x2 __attribute__((ext_vector_type(2)));
typedef unsigned u32x2 __attribute__((ext_vector_type(2)));
typedef float f32x16 __attribute__((ext_vector_type(16)));
typedef short s16x4 __attribute__((ext_vector_type(4)));

constexpr int NWAVES = 8, NTHR = 512;
constexpr int DM = 2048, NCTX = 4096, NLAT = 8192, NTOK = 12288, DEPTH = 4, INW = 5120, FFH = 5632, FF2 = 11264;
constexpr float EPS = 1e-6f;
constexpr size_t O_YP = 0, O_YS = 8388608, O_CA = 25165824, O_ST = 41943040, O_CC = 42008576, O_CD = 58785792;

constexpr size_t MiB = 1u << 20;
constexpr size_t al(size_t x) { return (x + 255) / 256 * 256; }
constexpr size_t WS_CTL = 0, CTL_ZERO_BYTES = 1 * MiB;
constexpr size_t WS_WIN = 1 * MiB;
constexpr size_t WS_WOUT = WS_WIN + (size_t)4 * INW * DM * 2;
constexpr size_t WS_WF1 = WS_WOUT + (size_t)4 * DM * DM * 2;
constexpr size_t WS_WF2 = WS_WF1 + (size_t)4 * FF2 * DM * 2;
constexpr size_t WS_GW = WS_WF2 + (size_t)4 * DM * FFH * 2;
constexpr size_t WS_MODV = WS_GW + (size_t)4 * 16 * 128 * 128 * 2;
constexpr size_t WS_ROPE = WS_MODV + (size_t)4 * 5 * 6 * 2048 * 4;
constexpr size_t WS_H = al(WS_ROPE + (size_t)(2 * 64 * 16 + 2 * 64 * 32) * 4);
constexpr size_t WS_QA = WS_H + (size_t)NTOK * DM * 2;
constexpr size_t WS_QC = WS_QA + (size_t)NTOK * 512 * 2;
constexpr size_t WS_QD = WS_QC + (size_t)NTOK * 512 * 2;
constexpr size_t WS_KA_CTX = WS_QD + (size_t)NTOK * 512 * 2;
constexpr size_t WS_VA_CTX = WS_KA_CTX + (size_t)NCTX * 512 * 2;
constexpr size_t WS_KC_CTX = WS_VA_CTX + (size_t)NCTX * 512 * 2;
constexpr size_t WS_VC_CTX = WS_KC_CTX + (size_t)NCTX * 512 * 2;
constexpr size_t WS_KD_CTX = WS_VC_CTX + (size_t)NCTX * 512 * 2;
constexpr size_t WS_VD_CTX = WS_KD_CTX + (size_t)NCTX * 256 * 2;
constexpr size_t WS_KA_LAT = WS_VD_CTX + (size_t)NCTX * 256 * 2;
constexpr size_t WS_VA_LAT = WS_KA_LAT + (size_t)4 * 2560 * 512 * 2;
constexpr size_t WS_KC_LAT = WS_VA_LAT + (size_t)4 * 2560 * 512 * 2;
constexpr size_t WS_VC_LAT = WS_KC_LAT + (size_t)4 * 2560 * 512 * 2;
constexpr size_t WS_KD_LAT = WS_VC_LAT + (size_t)4 * 2560 * 512 * 2;
constexpr size_t WS_VD_LAT = WS_KD_LAT + (size_t)4 * 2560 * 256 * 2;
constexpr size_t WS_BXG = WS_VD_LAT + (size_t)4 * 2560 * 256 * 2 + 4096;
constexpr size_t WS_MIX = WS_BXG + (size_t)NTOK * 1024 * 4;
constexpr size_t WS_Y = WS_MIX + (size_t)NTOK * DM * 2;
constexpr size_t WS_T = WS_Y + (size_t)NTOK * DM * 4;
constexpr size_t WS_SUM = WS_T + (size_t)NTOK * FFH * 2;
constexpr size_t WS_PARK = WS_SUM + (size_t)192 * 2 * 512 * 2 * 4;
constexpr size_t WS_FAST_END = WS_PARK + (size_t)256 * 64 * 512 * 4;

constexpr int CW_BAR = 4096;

constexpr int LDS_BYTES = 147456;
constexpr int LDSCTL_OFF = LDS_BYTES - 512, MISC_OFF = LDSCTL_OFF + 320;

#define LDS_WAIT() asm volatile("s_waitcnt lgkmcnt(0)" ::: "memory")
#define VM_WAIT() asm volatile("s_waitcnt vmcnt(0)" ::: "memory")
__device__ __forceinline__ unsigned f2bf(float f) { unsigned u = __builtin_bit_cast(unsigned, f); return (u + 0x7fffu + ((u >> 16) & 1u)) >> 16; }
__device__ __forceinline__ unsigned pk2(float lo, float hi) { return f2bf(lo) | (f2bf(hi) << 16); }
__device__ __forceinline__ float bf2f(unsigned short b) { return __builtin_bit_cast(float, ((unsigned)b) << 16); }
__device__ __forceinline__ float bflo(unsigned w) { return __builtin_bit_cast(float, w << 16); }
__device__ __forceinline__ float bfhi(unsigned w) { return __builtin_bit_cast(float, w & 0xffff0000u); }
__device__ __forceinline__ float wave_sum(float v) {
#pragma unroll
    for (int o = 1; o < 64; o <<= 1) v += __shfl_xor(v, o);
    return v;
}
__device__ __forceinline__ float sigmoidf_(float x) { return 1.f / (1.f + __expf(-x)); }

struct Params {
    const float *x_prompt, *x_sample, *cache_a, *state, *cache_c, *cache_d, *c, *c_ctx, *w_mod, *b_mod, *norm_g, *w_in, *lam_w, *conv_w, *conv_b, *gate_w, *gate_b, *lru_lam, *rpb, *qk_g, *w_out, *w_ffn_in, *w_ffn_out;
    float* out; unsigned char* ws;
    int ph_lo, ph_hi;
};
static_assert(sizeof(Params) == 25 * 8 + 8, "Params has no padding");

#define CAS __attribute__((address_space(4)))
struct Frame {
    LAS unsigned char* lds;
    int tid, lane, wave, G, wg;
    const CAS Params* p;
    unsigned char* ws;
};
__device__ __forceinline__ void fresh(Frame& F) { int t = threadIdx.x; asm volatile("" : "+v"(t)); F.tid = t; F.lane = t & 63;
    const CAS Params* q = (const CAS Params*)__builtin_amdgcn_kernarg_segment_ptr(); asm volatile("" : "+s"(q)); F.p = q; F.ws = q->ws; }
__device__ __forceinline__ int cond_of_row(int row) { return row < NCTX ? 0 : 1 + ((row - NCTX) >> 11); }
}
namespace mk {
struct EpiF32 {
    static constexpr bool PERM = false, AFTER_DRAIN = false;
    float* C; int ldc;
    __device__ __forceinline__ void operator()(const f32x4 (&acc)[2][2][4][2], const Unit& u, int wr, int wc, int fr, int fq) const {
        const int row0 = u.pm * 256 + wr * 64 + fr, col0 = u.pn * 256 + wc * 32 + 4 * fq;
#pragma unroll
        for (int ai = 0; ai < 2; ++ai)
#pragma unroll
            for (int m = 0; m < 4; ++m) { float* rowp = C + (size_t)(row0 + ai * 128 + m * 16) * ldc + col0;
#pragma unroll
                for (int bj = 0; bj < 2; ++bj)
#pragma unroll
                    for (int n = 0; n < 2; ++n) *(f32x4*)(rowp + bj * 128 + n * 16) = acc[ai][bj][m][n]; }
    }
};
struct EpiIn {
    static constexpr bool PERM = true, AFTER_DRAIN = false;
    unsigned char* ws; float* out; int l;
    __device__ __forceinline__ void operator()(const f32x4 (&acc)[2][2][4][2], const Unit& u, int wr, int wc, int fr, int fq) const {
        const int pm = u.pm, pn = u.pn;
        const bool ctx = pm < 16; const int b = ctx ? pm : ((pm - 16) >> 3); const int t0 = ctx ? 0 : ((pm - 16) & 7) * 256;
        const size_t rowg = (size_t)pm * 256;
        bf16* bd = nullptr; int bld = 512; float* fd = nullptr; int fld = 512;
        const size_t lat512 = ((size_t)b * 2560 + 512 + t0) * 512, ctx512 = (size_t)b * 256 * 512;
        const size_t lat256 = ((size_t)b * 2560 + 512 + t0) * 256, ctx256 = (size_t)b * 256 * 256;
        const size_t oc512k = ((((size_t)b * 4 + l) * 2 + 0) * 256) * 512, oc512v = ((((size_t)b * 4 + l) * 2 + 1) * 256) * 512;
        const size_t oc256k = ((((size_t)b * 4 + l) * 2 + 0) * 256) * 256, oc256v = ((((size_t)b * 4 + l) * 2 + 1) * 256) * 256;
        const int ph = (pn & 1) * 256;
        if (pn < 2) { bd = (bf16*)(ws + WS_QA) + rowg * 512 + ph; }
        else if (pn < 4) { if (ctx) { bd = (bf16*)(ws + WS_KA_CTX) + ctx512 + ph; fd = out + O_CA + oc512k + ph; } else bd = (bf16*)(ws + WS_KA_LAT) + lat512 + ph; }
        else if (pn < 6) { if (ctx) { bd = (bf16*)(ws + WS_VA_CTX) + ctx512 + ph; fd = out + O_CA + oc512v + ph; } else bd = (bf16*)(ws + WS_VA_LAT) + lat512 + ph; }
        else if (pn < 10) { fd = (float*)(ws + WS_BXG) + rowg * 1024 + (pn - 6) * 256; fld = 1024; }
        else if (pn < 12) { bd = (bf16*)(ws + WS_QC) + rowg * 512 + ph; }
        else if (pn < 14) { if (ctx) { bd = (bf16*)(ws + WS_KC_CTX) + ctx512 + ph; fd = out + O_CC + oc512k + ph; } else bd = (bf16*)(ws + WS_KC_LAT) + lat512 + ph; }
        else if (pn < 16) { if (ctx) { bd = (bf16*)(ws + WS_VC_CTX) + ctx512 + ph; fd = out + O_CC + oc512v + ph; } else bd = (bf16*)(ws + WS_VC_LAT) + lat512 + ph; }
        else if (pn < 18) { bd = (bf16*)(ws + WS_QD) + rowg * 512 + ph; }
        else if (pn == 18) { bld = 256; if (ctx) bd = (bf16*)(ws + WS_KD_CTX) + ctx256; else bd = (bf16*)(ws + WS_KD_LAT) + lat256; }
        else { bld = 256; fld = 256; if (ctx) { bd = (bf16*)(ws + WS_VD_CTX) + ctx256; fd = out + O_CD + oc256v; } else bd = (bf16*)(ws + WS_VD_LAT) + lat256; }
        (void)oc256k;
        const int rl0 = wr * 64 + fr, cl0 = wc * 32 + 8 * fq;
#pragma unroll
        for (int ai = 0; ai < 2; ++ai)
#pragma unroll
            for (int m = 0; m < 4; ++m) { const int rl = rl0 + ai * 128 + m * 16;
#pragma unroll
                for (int bj = 0; bj < 2; ++bj) { const f32x4 v0 = acc[ai][bj][m][0], v1 = acc[ai][bj][m][1]; const int cl = cl0 + bj * 128;
                    if (bd) { u32x4 w; w.x = pg8::cvt_pk_bf16(v0[0], v0[1]); w.y = pg8::cvt_pk_bf16(v0[2], v0[3]); w.z = pg8::cvt_pk_bf16(v1[0], v1[1]); w.w = pg8::cvt_pk_bf16(v1[2], v1[3]);
                        *(u32x4*)(bd + (size_t)rl * bld + cl) = w; }
                    if (fd) { *(f32x4*)(fd + (size_t)rl * fld + cl) = v0; *(f32x4*)(fd + (size_t)rl * fld + cl + 4) = v1; } } }
    }
};
struct EpiSwiglu {
    static constexpr bool PERM = true, AFTER_DRAIN = false;
    bf16* T;
    __device__ __forceinline__ void operator()(const f32x4 (&acc)[2][2][4][2], const Unit& u, int wr, int wc, int fr, int fq) const {
        const int row0 = u.pm * 256 + wr * 64 + fr, col0 = u.pn * 128 + wc * 32 + 8 * fq;
#pragma unroll
        for (int ai = 0; ai < 2; ++ai)
#pragma unroll
            for (int m = 0; m < 4; ++m) { float r[8];
#pragma unroll
                for (int n = 0; n < 2; ++n)
#pragma unroll
                    for (int j = 0; j < 4; ++j) { const float a = acc[ai][0][m][n][j], g = acc[ai][1][m][n][j]; r[4 * n + j] = a * g * __builtin_amdgcn_rcpf(1.f + __expf(-g)); }
                u32x4 w; w.x = pg8::cvt_pk_bf16(r[0], r[1]); w.y = pg8::cvt_pk_bf16(r[2], r[3]); w.z = pg8::cvt_pk_bf16(r[4], r[5]); w.w = pg8::cvt_pk_bf16(r[6], r[7]);
                *(u32x4*)(T + (size_t)(row0 + ai * 128 + m * 16) * FFH + col0) = w; }
    }
};

template <int MODE  >
__device__ __forceinline__ void transpose_item(const float* W, int K, int N, bf16* WT, LAS float* scr, int item, int lane) {
    const int nblk = N / 32, kb = item / nblk, nb = item % nblk, k0 = 64 * kb, n0 = 32 * nb;
#pragma unroll 8
    for (int i = 0; i < 32; ++i) { const int kk = 2 * i + (lane >> 5); scr[kk * 33 + (lane & 31)] = W[(size_t)(k0 + kk) * N + n0 + (lane & 31)]; }
    LDS_WAIT(); asm volatile("" ::: "memory");
    int r0 = n0;
    if (MODE == 1) { r0 = n0 < FFH ? 256 * (n0 / 128) + (n0 % 128) : 256 * ((n0 - FFH) / 128) + 128 + ((n0 - FFH) % 128); }
    const int c = lane & 7;
#pragma unroll
    for (int j = 0; j < 4; ++j) { const int n = (lane >> 3) + 8 * j; const LAS float* s = scr + (8 * c) * 33 + n;
        u32x4 o; o.x = pk2(s[0 * 33], s[1 * 33]); o.y = pk2(s[2 * 33], s[3 * 33]); o.z = pk2(s[4 * 33], s[5 * 33]); o.w = pk2(s[6 * 33], s[7 * 33]);
        *(GAS u32x4*)(WT + (size_t)(r0 + n) * K + k0 + 8 * c) = o; }
    LDS_WAIT(); asm volatile("" ::: "memory");
}
__device__ __forceinline__ void mod_unit(Frame& F, int unit) {
    fresh(F);
    const int l = unit >> 6, cg = unit & 63, tid = F.tid;
    LAS float* sl = (LAS float*)F.lds;
    LAS float* red = (LAS float*)(F.lds + 40960);
    LAS float* fin = (LAS float*)(F.lds + 40960 + 38400);
    for (int i = tid; i < 5 * 2048; i += NTHR) { const int ci = i >> 11, k = i & 2047; const float x = ci == 0 ? F.p->c_ctx[k] : F.p->c[(ci - 1) * 2048 + k]; sl[i] = x / (1.f + expf(-x)); }
    __syncthreads();
    if (tid < 480) {
        const int q = tid % 48, ks = tid / 48, chunk = q >> 3, cq = q & 7;
        const float* w = F.p->w_mod + (size_t)l * 2048 * 12288 + chunk * 2048 + cg * 32 + cq * 4;
        f32x4 acc[5];
#pragma unroll
        for (int ci = 0; ci < 5; ++ci) acc[ci] = (f32x4){0.f, 0.f, 0.f, 0.f};
#pragma unroll 5
        for (int k = ks; k < 2048; k += 10) { const f32x4 wv = *(const f32x4*)(w + (size_t)k * 12288);
#pragma unroll
            for (int ci = 0; ci < 5; ++ci) acc[ci] += wv * sl[ci * 2048 + k]; }
#pragma unroll
        for (int ci = 0; ci < 5; ++ci) *(LAS f32x4*)(red + ((ks * 48 + q) * 5 + ci) * 4) = acc[ci];
    }
    __syncthreads();
    for (int o = tid; o < 5 * 6 * 32; o += NTHR) { const int ci = o / 192, r = o % 192, chunk = r >> 5, cc = r & 31, q = chunk * 8 + (cc >> 2);
        float s = F.p->b_mod[(size_t)l * 12288 + chunk * 2048 + cg * 32 + cc];
        for (int ks = 0; ks < 10; ++ks) s += red[((ks * 48 + q) * 5 + ci) * 4 + (cc & 3)];
        fin[o] = s; }
    __syncthreads();
    float* mv = (float*)(F.ws + WS_MODV);
    for (int o = tid; o < 5 * 32; o += NTHR) { const int ci = o >> 5, cc = o & 31, c = cg * 32 + cc; const LAS float* f = fin + ci * 192;
        const float* ng = F.p->norm_g + (size_t)l * 4 * 2048;
        float* d = mv + (((size_t)l * 5 + ci) * 6) * 2048 + c;
        d[0 * 2048] = ng[c] * (1.f + f[1 * 32 + cc]); d[1 * 2048] = f[0 * 32 + cc]; d[2 * 2048] = f[2 * 32 + cc] * ng[2048 + c];
        d[3 * 2048] = ng[2 * 2048 + c] * (1.f + f[4 * 32 + cc]); d[4 * 2048] = f[3 * 32 + cc]; d[5 * 2048] = f[5 * 32 + cc] * ng[3 * 2048 + c]; }
    __syncthreads();
}
__device__ __forceinline__ void ph_prologue(Frame& F) {
    for (int u = F.wg; u < 256; u += F.G) mod_unit(F, u);
    fresh(F);
    { float* rt = (float*)(F.ws + WS_ROPE);
      for (int i = F.wg * NTHR + F.tid; i < 64 * 16 + 64 * 32; i += F.G * NTHR) {
          if (i < 1024) { const int pos = i >> 4, fi = i & 15; const float ang = (float)pos * powf(10000.f, -(float)(2 * fi) / 32.f); rt[i] = cosf(ang); rt[1024 + i] = sinf(ang); }
          else { const int k = i - 1024, pos = k >> 5, fi = k & 31; const float ang = (float)pos * powf(10000.f, -(float)(2 * fi) / 64.f); rt[2048 + k] = cosf(ang); rt[2048 + 2048 + k] = sinf(ang); } } }
    LAS float* scr = (LAS float*)(F.lds + F.wave * 16384);
    const int gw = F.wg * NWAVES + F.wave, NGW = F.G * NWAVES;
    constexpr int I_IN = (DM / 64) * (INW / 32), I_OUT = (DM / 64) * (DM / 32), I_F1 = (DM / 64) * (FF2 / 32), I_F2 = (FFH / 64) * (DM / 32), I_L = I_IN + I_OUT + I_F1 + I_F2;
    constexpr int I_G = 64 * 8;
    for (int it = gw; it < DEPTH * I_L + I_G; it += NGW) {
        if (it >= DEPTH * I_L) { const int g = it - DEPTH * I_L, mat = g >> 3, sub = g & 7;
            transpose_item<0>(F.p->gate_w + (size_t)mat * 16384, 128, 128, (bf16*)(F.ws + WS_GW) + (size_t)mat * 16384, scr, sub, F.lane); continue; }
        const int l = it / I_L; int r = it % I_L;
        if (r < I_IN) { transpose_item<0>(F.p->w_in + (size_t)l * DM * INW, DM, INW, (bf16*)(F.ws + WS_WIN) + (size_t)l * INW * DM, scr, r, F.lane); continue; } r -= I_IN;
        if (r < I_OUT) { transpose_item<0>(F.p->w_out + (size_t)l * DM * DM, DM, DM, (bf16*)(F.ws + WS_WOUT) + (size_t)l * DM * DM, scr, r, F.lane); continue; } r -= I_OUT;
        if (r < I_F1) { transpose_item<1>(F.p->w_ffn_in + (size_t)l * DM * FF2, DM, FF2, (bf16*)(F.ws + WS_WF1) + (size_t)l * FF2 * DM, scr, r, F.lane); continue; } r -= I_F1;
        transpose_item<0>(F.p->w_ffn_out + (size_t)l * FFH * DM, FFH, DM, (bf16*)(F.ws + WS_WF2) + (size_t)l * DM * FFH, scr, r, F.lane);
    }
}

__device__ __forceinline__ void ph_norm0(Frame& F) {
    fresh(F);
    const int gw = F.wg * NWAVES + F.wave, NGW = F.G * NWAVES;
    const float* mv = (const float*)(F.ws + WS_MODV);
    for (int row = gw; row < NTOK; row += NGW) {
        const float* xin = row < NCTX ? F.p->x_prompt + (size_t)row * DM : F.p->x_sample + (size_t)(row - NCTX) * DM;
        const GAS f32x4* xr = (const GAS f32x4*)xin + F.lane; f32x4 v[8]; float ss = 0.f;
#pragma unroll
        for (int j = 0; j < 8; ++j) { v[j] = xr[64 * j]; ss += (v[j].x * v[j].x + v[j].y * v[j].y) + (v[j].z * v[j].z + v[j].w * v[j].w); }
        const float rs = rsqrtf(wave_sum(ss) * (1.f / DM) + EPS);
        GAS f32x4* xo = (GAS f32x4*)(F.p->out + (size_t)row * DM) + F.lane;
        const GAS f32x4* sm = (const GAS f32x4*)(mv + ((size_t)(0 * 5 + cond_of_row(row)) * 6 + 0) * 2048) + F.lane;
        GAS u32x2* ho = (GAS u32x2*)((bf16*)(F.ws + WS_H) + (size_t)row * DM) + F.lane;
#pragma unroll
        for (int j = 0; j < 8; ++j) { xo[64 * j] = v[j]; const f32x4 s = sm[64 * j], sh = sm[512 + 64 * j]; const f32x4 h = v[j] * rs * s + sh;
            u32x2 w; w.x = pk2(h.x, h.y); w.y = pk2(h.z, h.w); ho[64 * j] = w; }
    }
}
__device__ __forceinline__ void ph_norm(Frame& F, int l, int vG, bool next, int ln, int vS) {
    fresh(F);
    const int gw = F.wg * NWAVES + F.wave, NGW = F.G * NWAVES;
    const float* mv = (const float*)(F.ws + WS_MODV);
    for (int row = gw; row < NTOK; row += NGW) {
        const int ci = cond_of_row(row);
        const GAS f32x4* yr = (const GAS f32x4*)((const float*)(F.ws + WS_Y) + (size_t)row * DM) + F.lane;
        GAS f32x4* xr = (GAS f32x4*)(F.p->out + (size_t)row * DM) + F.lane;
        const GAS f32x4* gv = (const GAS f32x4*)(mv + ((size_t)(l * 5 + ci) * 6 + vG) * 2048) + F.lane;
        f32x4 y[8], x[8]; float ss = 0.f;
#pragma unroll
        for (int j = 0; j < 8; ++j) { y[j] = yr[64 * j]; x[j] = xr[64 * j]; ss += (y[j].x * y[j].x + y[j].y * y[j].y) + (y[j].z * y[j].z + y[j].w * y[j].w); }
        const float rs = rsqrtf(wave_sum(ss) * (1.f / DM) + EPS); float s2 = 0.f;
#pragma unroll
        for (int j = 0; j < 8; ++j) { x[j] = x[j] + gv[64 * j] * (y[j] * rs); xr[64 * j] = x[j]; s2 += (x[j].x * x[j].x + x[j].y * x[j].y) + (x[j].z * x[j].z + x[j].w * x[j].w); }
        if (next) {
            const float r2 = rsqrtf(wave_sum(s2) * (1.f / DM) + EPS);
            const GAS f32x4* sm = (const GAS f32x4*)(mv + ((size_t)(ln * 5 + ci) * 6 + vS) * 2048) + F.lane;
            GAS u32x2* ho = (GAS u32x2*)((bf16*)(F.ws + WS_H) + (size_t)row * DM) + F.lane;
#pragma unroll
            for (int j = 0; j < 8; ++j) { const f32x4 h = x[j] * r2 * sm[64 * j] + sm[512 + 64 * j]; u32x2 w; w.x = pk2(h.x, h.y); w.y = pk2(h.z, h.w); ho[64 * j] = w; }
        }
    }
}

__device__ __forceinline__ void ph_prep_items(Frame& F, int l) {
    fresh(F);
    const int gw = F.wg * NWAVES + F.wave, NGW = F.G * NWAVES, lane = F.lane;
    for (int it = gw; it < 3 * 4096; it += NGW) {
        const int which = it >> 12, r = it & 4095, b = r >> 10, kv = (r >> 9) & 1, p = r & 511;
        if (which < 2) { const float* src = (which == 0 ? F.p->cache_a : F.p->cache_c) + ((((size_t)b * 4 + l) * 2 + kv) * 512 + p) * 512 + lane * 8;
            bf16* dst = (bf16*)(F.ws + (which == 0 ? (kv ? WS_VA_LAT : WS_KA_LAT) : (kv ? WS_VC_LAT : WS_KC_LAT))) + ((size_t)b * 2560 + p) * 512 + lane * 8;
            const f32x4 a = *(const f32x4*)src, c = *(const f32x4*)(src + 4); u32x4 w; w.x = pk2(a.x, a.y); w.y = pk2(a.z, a.w); w.z = pk2(c.x, c.y); w.w = pk2(c.z, c.w); *(u32x4*)dst = w; }
        else { const float* src = F.p->cache_d + ((((size_t)b * 4 + l) * 2 + kv) * 512 + p) * 256 + lane * 4;
            bf16* dst = (bf16*)(F.ws + (kv ? WS_VD_LAT : WS_KD_LAT)) + ((size_t)b * 2560 + p) * 256 + lane * 4;
            const f32x4 a = *(const f32x4*)src; u32x2 w; w.x = pk2(a.x, a.y); w.y = pk2(a.z, a.w); *(u32x2*)dst = w; }
    }
    const float* rt = (const float*)(F.ws + WS_ROPE);
    const int sub = lane >> 4, j8 = lane & 15;
    constexpr int N0 = NTOK * 4, N1 = NTOK * 2, N2 = NLAT * 4, N3 = NLAT * 4;
    for (int it = gw; it < (N0 + N1 + N2 + N3) / 4; it += NGW) {
        int rh = it * 4 + sub; int type = 0;
        if (rh >= N0) { rh -= N0; type = 1; if (rh >= N1) { rh -= N1; type = 2; if (rh >= N2) { rh -= N2; type = 3; } } }
        int row, head; bf16* p; float* fo = nullptr;
        if (type == 0) { row = rh >> 2; head = rh & 3; p = (bf16*)(F.ws + WS_QD) + (size_t)row * 512 + head * 128; }
        else if (type == 1) { row = rh >> 1; head = rh & 1;
            if (row < NCTX) { p = (bf16*)(F.ws + WS_KD_CTX) + (size_t)row * 256 + head * 128; const int b = row >> 8, s = row & 255; fo = F.p->out + O_CD + ((((size_t)b * 4 + l) * 2 + 0) * 256 + s) * 256 + head * 128; }
            else { const int b = (row - NCTX) >> 11, t = (row - NCTX) & 2047; p = (bf16*)(F.ws + WS_KD_LAT) + ((size_t)b * 2560 + 512 + t) * 256 + head * 128; } }
        else if (type == 2) { row = NCTX + (rh >> 2); head = rh & 3; p = (bf16*)(F.ws + WS_QA) + (size_t)row * 512 + head * 128; }
        else { row = NCTX + (rh >> 2); head = rh & 3; const int b = (row - NCTX) >> 11, t = (row - NCTX) & 2047; p = (bf16*)(F.ws + WS_KA_LAT) + ((size_t)b * 2560 + 512 + t) * 512 + head * 128; }
        const bool lat = row >= NCTX; const int t = lat ? ((row - NCTX) & 2047) : 0; const int prow = t >> 6, pcol = t & 63;
        p += j8 * 8;
        const u32x4 raw = *(const u32x4*)p;
        float x[8] = {bflo(raw.x), bfhi(raw.x), bflo(raw.y), bfhi(raw.y), bflo(raw.z), bfhi(raw.z), bflo(raw.w), bfhi(raw.w)};
        if (type < 2) {
            float ss = 0.f;
#pragma unroll
            for (int i = 0; i < 8; ++i) ss += x[i] * x[i];
            ss += __shfl_xor(ss, 1); ss += __shfl_xor(ss, 2); ss += __shfl_xor(ss, 4); ss += __shfl_xor(ss, 8);
            const float rs = rsqrtf(ss * (1.f / 128.f) + EPS); const float* g = F.p->qk_g + (size_t)l * 256 + type * 128 + j8 * 8;
#pragma unroll
            for (int i = 0; i < 8; ++i) x[i] = x[i] * rs * g[i];
            if (fo) { *(f32x4*)(fo + j8 * 8) = (f32x4){x[0], x[1], x[2], x[3]}; *(f32x4*)(fo + j8 * 8 + 4) = (f32x4){x[4], x[5], x[6], x[7]}; }
        }
        if (lat) {
            const int px = type < 2 ? 4 : 2;
            float y[8];
#pragma unroll
            for (int i = 0; i < 8; ++i) y[i] = __shfl_xor(x[i], px);
            const bool hi_half = (j8 & px) != 0;
            int pos, fbase; const float *ct, *st;
            if (type < 2) { pos = (j8 & 8) ? pcol : prow; fbase = (j8 & 3) * 8; ct = rt + 2048 + pos * 32 + fbase; st = rt + 4096 + pos * 32 + fbase; }
            else { pos = (j8 & 4) ? pcol : prow; fbase = (j8 & 1) * 8; ct = rt + pos * 16 + fbase; st = rt + 1024 + pos * 16 + fbase; }
#pragma unroll
            for (int i = 0; i < 8; ++i) { const float c = ct[i], s = st[i]; x[i] = hi_half ? (y[i] * s + x[i] * c) : (x[i] * c - y[i] * s); }
        }
        u32x4 w; w.x = pk2(x[0], x[1]); w.y = pk2(x[2], x[3]); w.z = pk2(x[4], x[5]); w.w = pk2(x[6], x[7]);
        *(u32x4*)p = w;
    }
}
}
namespace mk {
constexpr int KVBLK = 64;
constexpr int SHM_V = KVBLK * 128 * 2, SHM_K = KVBLK * 128 * 2;
constexpr int ATT_WS_OFF = 2 * SHM_V + 2 * SHM_K;
constexpr int ATT_TAB_OFF = ATT_WS_OFF + 8 * 64 * 4;
constexpr int ATT_Q_OFF = ATT_TAB_OFF + 15 * 32 * 4;
constexpr int ATT_LDS = ATT_Q_OFF + 8 * 8 * 64 * 16;
static_assert(ATT_LDS <= LDSCTL_OFF, "attention scratch below the LDS control words");
#define KSWZ(row, colB) ((row) * 256 + ((colB) ^ (((row) & 7) << 4)))
#define SBAR() __builtin_amdgcn_sched_barrier(0)
__device__ __forceinline__ int crow(int r, int hi) { return (r & 3) + 8 * (r >> 2) + 4 * hi; }
__device__ __forceinline__ unsigned cvtpk(float lo, float hi) { unsigned r; asm volatile("v_cvt_pk_bf16_f32 %0, %1, %2" : "=v"(r) : "v"(lo), "v"(hi)); return r; }
constexpr float ATT_THR = 8.f;
#ifndef ATT_SDEPTH
#define ATT_SDEPTH 1
#endif
constexpr int SDEPTH = ATT_SDEPTH;
#ifndef ATT_QREG8
#define ATT_QREG8 8
#endif

struct AttnDesc {
    const bf16* Q; const bf16* K; const bf16* V; int ldq, ldk;
    int kd0;
    int nt, nt0, base1;
    int na, r0, kr_lo;
    int omode;
    bf16* O; int ldo; float* park; float lam, oscale;
};

template <int ND0> __device__ __forceinline__ void partialSM(f32x16& p0, f32x16& p1, float& m_reg, float& mn, float& alpha) {
    constexpr float SCALE = ND0 == 4 ? 0.125f : 0.08838834764831845f;
    constexpr float C = SCALE * 1.4426950408889634f;
    float pmax = p0[0];
#pragma unroll
    for (int r = 1; r < 16; ++r) pmax = fmaxf(pmax, p0[r]);
#pragma unroll
    for (int r = 0; r < 16; ++r) pmax = fmaxf(pmax, p1[r]);
    { auto rr = __builtin_amdgcn_permlane32_swap(__float_as_uint(pmax), __float_as_uint(pmax), false, false);
      pmax = fmaxf(__uint_as_float(rr[0]), __uint_as_float(rr[1])); }
    if (__builtin_expect(__all(pmax - m_reg <= ATT_THR / SCALE), 1)) { mn = m_reg; alpha = 1.f; }
    else { mn = fmaxf(m_reg, pmax); alpha = __builtin_amdgcn_exp2f((m_reg - mn) * C); m_reg = mn; }
    const float mnC = -mn * C;
#pragma unroll
    for (int r = 0; r < 16; ++r) p0[r] = fmaf(p0[r], C, mnC);
#pragma unroll
    for (int r = 0; r < 16; ++r) p1[r] = fmaf(p1[r], C, mnC);
#pragma unroll
    for (int r = 0; r < 16; ++r) p0[r] = __builtin_amdgcn_exp2f(p0[r]);
}
__device__ __forceinline__ void finishSM(f32x16& p0, f32x16& p1, float alpha, float& l_reg, bf16x8& pa0, bf16x8& pa1, bf16x8& pa2, bf16x8& pa3) {
#pragma unroll
    for (int r = 0; r < 16; ++r) p1[r] = __builtin_amdgcn_exp2f(p1[r]);
    float ps = 0;
#pragma unroll
    for (int r = 0; r < 16; ++r) ps += p0[r];
#pragma unroll
    for (int r = 0; r < 16; ++r) ps += p1[r];
    { auto rr = __builtin_amdgcn_permlane32_swap(__float_as_uint(ps), __float_as_uint(ps), false, false);
      ps = __uint_as_float(rr[0]) + __uint_as_float(rr[1]); }
    l_reg = l_reg * alpha + ps;
#define PK4(P, BASE, OUT) do { unsigned a0 = cvtpk(P[BASE + 0], P[BASE + 1]), a1 = cvtpk(P[BASE + 2], P[BASE + 3]);   \
    unsigned b0 = cvtpk(P[BASE + 4], P[BASE + 5]), b1 = cvtpk(P[BASE + 6], P[BASE + 7]);                              \
    auto r0 = __builtin_amdgcn_permlane32_swap(a0, b0, false, false); auto r1 = __builtin_amdgcn_permlane32_swap(a1, b1, false, false); \
    u32x4 w = {r0[0], r1[0], r0[1], r1[1]}; OUT = *reinterpret_cast<bf16x8*>(&w); } while (0)
    PK4(p0, 0, pa0); PK4(p0, 8, pa1); PK4(p1, 0, pa2); PK4(p1, 8, pa3);
#undef PK4
}
template <int ND0, int QREG> __device__ __forceinline__ void qkt(f32x16& p0, f32x16& p1, const LAS char* Ks, const bf16x8* qr, const LAS bf16x8* ql, int kd0, int r32, int hi) {
    p0 = f32x16{}; p1 = f32x16{};
#pragma unroll
    for (int d0 = 0; d0 < ND0; ++d0) { const int cb = ((d0 + kd0) * 16 + hi * 8) * 2;
        const bf16x8 b0 = *reinterpret_cast<const LAS bf16x8*>(Ks + KSWZ(r32, cb));
        const bf16x8 b1 = *reinterpret_cast<const LAS bf16x8*>(Ks + KSWZ(32 + r32, cb));
        bf16x8 qv; if (d0 < QREG) qv = qr[d0 < QREG ? d0 : 0]; else qv = ql[d0 * 64];
        p0 = __builtin_amdgcn_mfma_f32_32x32x16_bf16(b0, qv, p0, 0, 0, 0);
        p1 = __builtin_amdgcn_mfma_f32_32x32x16_bf16(b1, qv, p1, 0, 0, 0); }
}
__device__ __forceinline__ int v_st(int k, int c) { const int kk = (k & ~0xC) | ((k & 4) << 1) | ((k & 8) >> 1); return ((kk >> 3) * 4 + (c >> 5)) * 512 + ((kk & 7) * 32 + (c & 31)) * 2; }
__device__ __forceinline__ int v_rd_base(int lane) { return ((lane & 3) << 3) | (((lane >> 2) & 3) << 6) | (((lane >> 4) & 1) << 5) | (((lane >> 5) & 1) << 8); }
constexpr int v_rd_off(int d0, int ks, int half) { return d0 * 512 + ks * 4096 + half * 2048; }
template <int OFF> __device__ __forceinline__ s16x4 tr_read(int vb) {
    s16x4 r; asm volatile("ds_read_b64_tr_b16 %0, %1 offset:%2" : "=&v"(r) : "v"(vb), "i"(OFF) : "memory"); return r;
}
template <int D0> __device__ __forceinline__ void pv_one(f32x16& od, int vb, bf16x8 pa0, bf16x8 pa1, bf16x8 pa2, bf16x8 pa3) {
    const s16x4 l0 = tr_read<v_rd_off(D0, 0, 0)>(vb), h0 = tr_read<v_rd_off(D0, 0, 1)>(vb), l1 = tr_read<v_rd_off(D0, 1, 0)>(vb), h1 = tr_read<v_rd_off(D0, 1, 1)>(vb);
    const s16x4 l2 = tr_read<v_rd_off(D0, 2, 0)>(vb), h2 = tr_read<v_rd_off(D0, 2, 1)>(vb), l3 = tr_read<v_rd_off(D0, 3, 0)>(vb), h3 = tr_read<v_rd_off(D0, 3, 1)>(vb);
    asm volatile("s_waitcnt lgkmcnt(0)" ::: "memory"); SBAR();
#define PK(L, H) (bf16x8){L[0], L[1], L[2], L[3], H[0], H[1], H[2], H[3]}
    od = __builtin_amdgcn_mfma_f32_32x32x16_bf16(pa0, PK(l0, h0), od, 0, 0, 0);
    od = __builtin_amdgcn_mfma_f32_32x32x16_bf16(pa1, PK(l1, h1), od, 0, 0, 0);
    od = __builtin_amdgcn_mfma_f32_32x32x16_bf16(pa2, PK(l2, h2), od, 0, 0, 0);
    od = __builtin_amdgcn_mfma_f32_32x32x16_bf16(pa3, PK(l3, h3), od, 0, 0, 0);
#undef PK
}
__device__ __forceinline__ void pv_d0(f32x16* o, int vb, bf16x8 pa0, bf16x8 pa1, bf16x8 pa2, bf16x8 pa3) {
    pv_one<0>(o[0], vb, pa0, pa1, pa2, pa3); pv_one<1>(o[1], vb, pa0, pa1, pa2, pa3); pv_one<2>(o[2], vb, pa0, pa1, pa2, pa3); pv_one<3>(o[3], vb, pa0, pa1, pa2, pa3);
}
__device__ __forceinline__ void na_mask(f32x16& p0, f32x16& p1, const LAS float* tab, int kr, int r, int w, int hi) {
    int start = r - 4; start = start < 0 ? 0 : (start > 24 ? 24 : start);
    const bool rowok = (kr >= start) && (kr < start + 8);
    int cs = w - 8; cs = cs < 0 ? 0 : (cs > 48 ? 48 : cs);
    if (!rowok) {
#pragma unroll
        for (int q = 0; q < 16; ++q) { p0[q] = -1e30f; p1[q] = -1e30f; }
        return; }
    int dr = kr - r + 7; dr = dr < 0 ? 0 : (dr > 14 ? 14 : dr);
    const LAS float* trow = tab + dr * 32;
#pragma unroll
    for (int q = 0; q < 16; ++q) {
        const int kc0 = crow(q, hi), kc1 = 32 + kc0;
        int d0 = kc0 - w + 15, d1 = kc1 - w + 15; d0 = d0 < 0 ? 0 : (d0 > 30 ? 30 : d0); d1 = d1 < 0 ? 0 : (d1 > 30 ? 30 : d1);
        const bool v0 = (kc0 >= cs) && (kc0 < cs + 16), v1 = (kc1 >= cs) && (kc1 < cs + 16);
        const float b0 = trow[d0], b1 = trow[d1];
        p0[q] = v0 ? p0[q] + b0 : -1e30f; p1[q] = v1 ? p1[q] + b1 : -1e30f;
        if ((q & 1) == 1) asm volatile("" ::: "memory");
    }
}

template <int ND0, int NA, int LDK>
__device__ __forceinline__ void attn_body(const AttnDesc& a, LAS char* lds) {
    int tid_ = threadIdx.x; asm volatile("" : "+v"(tid_));
    const int tid = tid_, wid = tid >> 6, lane = tid & 63, r32 = lane & 31, hi = lane >> 5;
    LAS char* V_lds = lds; LAS char* K_lds = lds + 2 * SHM_V;
    LAS float* wsf = (LAS float*)(lds + ATT_WS_OFF) + wid * 64; LAS float* li_l = wsf; LAS float* al_l = wsf + 32;
    const LAS float* tab = (const LAS float*)(lds + ATT_TAB_OFF);
    constexpr int QREG = NA ? 0 : (ND0 == 8 ? ATT_QREG8 : ND0);
    float m_reg = -1e30f, l_reg = 0; f32x16 o[4] = {}; bf16x8 qr[QREG ? QREG : 1];
    const bf16* Qw = a.Q + (size_t)(wid * 32 + r32) * a.ldq + hi * 8;
    LAS bf16x8* ql = (LAS bf16x8*)(lds + ATT_Q_OFF) + wid * (8 * 64) + lane;
#pragma unroll
    for (int d0 = 0; d0 < ND0; ++d0) { const bf16x8 qv = *reinterpret_cast<const bf16x8*>(Qw + d0 * 16); if (d0 < QREG) qr[d0 < QREG ? d0 : 0] = qv; else ql[d0 * 64] = qv; }
    const int sr = tid >> 4, sc = (tid & 15) * 8, vst0 = v_st(sr, sc), vst1 = v_st(32 + sr, sc);
    const int vb0 = (int)(uintptr_t)V_lds + v_rd_base(lane);
    constexpr int ldk = LDK; const bf16* __restrict__ Kh = a.K; const bf16* __restrict__ Vh = a.V;
    const int nt = a.nt, nt0 = a.nt0, base1 = a.base1, kd0 = a.kd0;
    const int qi = wid * 32 + r32, na_r = a.r0 + (qi >> 6), na_w = qi & 63;
    struct { bf16x8 vs0, vs1, ks0, ks1; } sr_[SDEPTH];
#define KOFF(j) ((j) < nt0 ? (j) * KVBLK : base1 + ((j) - nt0) * KVBLK)
#define SLOAD(i, k0) do { const size_t _k0 = (size_t)(k0); sr_[i].vs0 = *reinterpret_cast<const bf16x8*>(&Vh[(_k0 + sr) * ldk + sc]); sr_[i].vs1 = *reinterpret_cast<const bf16x8*>(&Vh[(_k0 + 32 + sr) * ldk + sc]); \
    sr_[i].ks0 = *reinterpret_cast<const bf16x8*>(&Kh[(_k0 + sr) * ldk + sc]); sr_[i].ks1 = *reinterpret_cast<const bf16x8*>(&Kh[(_k0 + 32 + sr) * ldk + sc]); } while (0)
#define SWRITE(b, i) do { *(LAS bf16x8*)(V_lds + (b) * SHM_V + vst0) = sr_[i].vs0;          \
    *(LAS bf16x8*)(V_lds + (b) * SHM_V + vst1) = sr_[i].vs1; const int kc = sc * 2;               \
    *(LAS bf16x8*)(K_lds + (b) * SHM_K + KSWZ(sr, kc)) = sr_[i].ks0;                       \
    *(LAS bf16x8*)(K_lds + (b) * SHM_K + KSWZ(32 + sr, kc)) = sr_[i].ks1; } while (0)
#define SWAIT() do { if constexpr (SDEPTH == 2) asm volatile("s_waitcnt vmcnt(4)" ::: "memory"); else asm volatile("s_waitcnt vmcnt(0)" ::: "memory"); } while (0)
#define RESC(al) do { if (__any((al) < 1.f)) { if (hi == 0) al_l[r32] = (al); asm volatile("s_waitcnt lgkmcnt(0)" ::: "memory"); \
    _Pragma("unroll") for (int d = 0; d < 4; ++d) _Pragma("unroll") for (int r = 0; r < 16; ++r) o[d][r] *= al_l[crow(r, hi)]; } } while (0)
#define MASK(P0, P1, j) do { if (NA && (j) >= nt0) na_mask(P0, P1, tab, a.kr_lo + (j) - nt0, na_r, na_w, hi); } while (0)
    f32x16 pA0, pA1, pB0, pB1; float mnA, mnB, alA, alB; bf16x8 pa0, pa1, pa2, pa3;
    constexpr int SE = 0, SO = SDEPTH - 1;
    SLOAD(SE, KOFF(0)); asm volatile("s_waitcnt vmcnt(0)" ::: "memory"); SWRITE(0, SE); __syncthreads();
    qkt<ND0, QREG>(pA0, pA1, K_lds, qr, ql, kd0, r32, hi); MASK(pA0, pA1, 0); partialSM<ND0>(pA0, pA1, m_reg, mnA, alA);
    SLOAD(SO, KOFF(1)); if constexpr (SDEPTH == 2) { if (2 < nt) SLOAD(SE, KOFF(2)); }
    SWAIT(); SWRITE(1, SO); __syncthreads();
    for (int j = 1; j + 1 < nt; j += 2) {
        SBAR(); qkt<ND0, QREG>(pB0, pB1, K_lds + SHM_K, qr, ql, kd0, r32, hi); MASK(pB0, pB1, j);
        finishSM(pA0, pA1, alA, l_reg, pa0, pa1, pa2, pa3); SBAR();
        SLOAD(SO, KOFF(j + SDEPTH)); SBAR();
        pv_d0(o, vb0, pa0, pa1, pa2, pa3); partialSM<ND0>(pB0, pB1, m_reg, mnB, alB);
        __syncthreads(); SWAIT(); SWRITE(0, SE);
        RESC(alB); __syncthreads();
        SBAR(); qkt<ND0, QREG>(pA0, pA1, K_lds, qr, ql, kd0, r32, hi); MASK(pA0, pA1, j + 1);
        finishSM(pB0, pB1, alB, l_reg, pa0, pa1, pa2, pa3); SBAR();
        if (SDEPTH == 1 || j + 3 < nt) SLOAD(SE, KOFF(j + 1 + SDEPTH)); SBAR();
        pv_d0(o, vb0 + SHM_V, pa0, pa1, pa2, pa3); partialSM<ND0>(pA0, pA1, m_reg, mnA, alA);
        __syncthreads(); SWAIT(); SWRITE(1, SO);
        RESC(alA); __syncthreads();
    }
    SBAR(); qkt<ND0, QREG>(pB0, pB1, K_lds + SHM_K, qr, ql, kd0, r32, hi); MASK(pB0, pB1, nt - 1);
    finishSM(pA0, pA1, alA, l_reg, pa0, pa1, pa2, pa3); SBAR();
    pv_d0(o, vb0, pa0, pa1, pa2, pa3); partialSM<ND0>(pB0, pB1, m_reg, mnB, alB);
    __syncthreads(); RESC(alB);
    finishSM(pB0, pB1, alB, l_reg, pa0, pa1, pa2, pa3); SBAR();
    pv_d0(o, vb0 + SHM_V, pa0, pa1, pa2, pa3);
    if (hi == 0) li_l[r32] = l_reg; asm volatile("s_waitcnt lgkmcnt(0)" ::: "memory");
    float rli[16];
#pragma unroll
    for (int r = 0; r < 16; ++r) rli[r] = __builtin_amdgcn_rcpf(li_l[crow(r, hi)]);
    if (a.omode == 1) {
        float* pk = a.park + tid;
#pragma unroll
        for (int d0 = 0; d0 < 4; ++d0)
#pragma unroll
            for (int r = 0; r < 16; ++r) pk[(d0 * 16 + r) * NTHR] = o[d0][r] * rli[r];
    } else {
        if (a.omode == 2) {
            const float* pk = a.park + tid;
#pragma unroll
            for (int r = 0; r < 16; ++r) { float ss = 0.f;
#pragma unroll
                for (int d0 = 0; d0 < 4; ++d0) { const float v = pk[(d0 * 16 + r) * NTHR] - a.lam * (o[d0][r] * rli[r]); o[d0][r] = v; ss += v * v; }
                ss += __shfl_xor(ss, 1); ss += __shfl_xor(ss, 2); ss += __shfl_xor(ss, 4); ss += __shfl_xor(ss, 8); ss += __shfl_xor(ss, 16);
                rli[r] = rsqrtf(ss * (1.f / 128.f) + EPS) * a.oscale; }
        }
        bf16* Ow = a.O + (size_t)(wid * 32) * a.ldo;
#pragma unroll
        for (int r = 0; r < 16; ++r) { const int orow = crow(r, hi);
#pragma unroll
            for (int d0 = 0; d0 < 4; ++d0) Ow[(size_t)orow * a.ldo + d0 * 32 + r32] = (bf16)f2bf(o[d0][r] * rli[r]); }
    }
    __syncthreads();
#undef KOFF
#undef SLOAD
#undef SWRITE
#undef SWAIT
#undef RESC
#undef MASK
}
}
namespace mk {
constexpr int LRU_XC_LD = 136;
__device__ __forceinline__ float gelu_tanh(float g) { const float u = 0.7978845608028654f * (g + 0.044715f * g * g * g); const float e = __expf(2.f * u); const float th = 1.f - 2.f * __builtin_amdgcn_rcpf(e + 1.f); return 0.5f * g * (1.f + th); }
template <int PASS>
__device__ __forceinline__ void lru_unit(Frame& F, int l, int unit) {
    int seq, n, chunk, S, row0, sumbase;
    if (unit < 512) { seq = 16 + (unit >> 7); n = (unit >> 5) & 3; chunk = unit & 31; S = 2048; row0 = NCTX + (seq - 16) * 2048; sumbase = (seq - 16) * 32; }
    else { const int u = unit - 512; seq = u >> 4; n = (u >> 2) & 3; chunk = u & 3; S = 256; row0 = seq * 256; sumbase = 128 + seq * 4; }
    const int nch = S >> 6, t0 = chunk * 64;
    fresh(F);
    const int tid = F.tid, lane = F.lane, w = F.wave, fr = lane & 15, fq = lane >> 4;
    LAS unsigned char* lds = F.lds;
    LAS bf16* xcT = (LAS bf16*)lds; LAS float* Abuf = (LAS float*)lds; LAS float* Bbuf = (LAS float*)(lds + 65536);
    const float* bxg = (const float*)(F.ws + WS_BXG);
    const int chl = 16 * w + fr, ch = n * 128 + chl;
    float xc[4][4];
    { const float* cw = F.p->conv_w + (size_t)l * 4 * 512 + ch; const float w0 = cw[0], w1 = cw[512], w2 = cw[1024], w3 = cw[1536], cb = F.p->conv_b[(size_t)l * 512 + ch];
#pragma unroll
      for (int mt = 0; mt < 4; ++mt) { const int tb = t0 + 16 * mt + 4 * fq; float xv[7];
#pragma unroll
          for (int i = 0; i < 7; ++i) { const int tt = tb - 2 + i; xv[i] = (tt >= 0 && tt < S) ? bxg[(size_t)(row0 + tt) * 1024 + ch] : 0.f; }
#pragma unroll
          for (int k = 0; k < 4; ++k) { xc[mt][k] = cb + w0 * xv[k] + w1 * xv[k + 1] + w2 * xv[k + 2] + w3 * xv[k + 3]; xcT[(16 * mt + 4 * fq + k) * LRU_XC_LD + chl] = (bf16)f2bf(xc[mt][k]); } } }
    __syncthreads();
    f32x4 acc[4][4];
    { const bf16* gw = (const bf16*)(F.ws + WS_GW) + (size_t)l * 16 * 16384;
#pragma unroll
      for (int dg = 0; dg < 4; ++dg)
#pragma unroll
          for (int mt = 0; mt < 4; ++mt) acc[dg][mt] = (f32x4){0.f, 0.f, 0.f, 0.f};
#pragma unroll
      for (int ks = 0; ks < 4; ++ks) { bf16x8 af[4];
#pragma unroll
          for (int mt = 0; mt < 4; ++mt) af[mt] = *(const LAS bf16x8*)(xcT + (16 * mt + fr) * LRU_XC_LD + 32 * ks + 8 * fq);
#pragma unroll
          for (int dg = 0; dg < 4; ++dg) { const bf16x8 bfr = *(const bf16x8*)(gw + ((size_t)(dg * 4 + n) * 128 + chl) * 128 + 32 * ks + 8 * fq);
#pragma unroll
              for (int mt = 0; mt < 4; ++mt) acc[dg][mt] = __builtin_amdgcn_mfma_f32_16x16x32_bf16(af[mt], bfr, acc[dg][mt], 0, 0, 0); } } }
    __syncthreads();
#pragma unroll
    for (int dir = 0; dir < 2; ++dir) {
        const float gbr = F.p->gate_b[((size_t)l * 2 + dir) * 2 * 512 + ch], gbi = F.p->gate_b[((size_t)l * 2 + dir) * 2 * 512 + 512 + ch];
        const float L = F.p->lru_lam[((size_t)l * 2 + dir) * 512 + ch]; const float sp = log1pf(expf(-L));
#pragma unroll
        for (int mt = 0; mt < 4; ++mt)
#pragma unroll
            for (int k = 0; k < 4; ++k) { const float r = 1.f / (1.f + expf(-(acc[dir * 2][mt][k] + gbr))), ig = 1.f / (1.f + expf(-(acc[dir * 2 + 1][mt][k] + gbi)));
                const float la = -8.f * r * sp; const float aa = expf(la), mult = sqrtf(-expm1f(2.f * la));
                const int tok = 16 * mt + 4 * fq + k; Abuf[(dir * 64 + tok) * 128 + chl] = aa; Bbuf[(dir * 64 + tok) * 128 + chl] = mult * ig * xc[mt][k]; }
    }
    __syncthreads();
    float* sum = (float*)(F.ws + WS_SUM);
    if (tid < 256) {
        const int dir = tid >> 7, c = tid & 127, cg = n * 128 + c;
        if (PASS == 1) {
            float h = 0.f, ap = 1.f;
            for (int s = 0; s < 64; ++s) { const int t = dir ? 63 - s : s; const float aa = Abuf[(dir * 64 + t) * 128 + c]; h = aa * h + Bbuf[(dir * 64 + t) * 128 + c]; ap *= aa; }
            *(f32x2*)(sum + ((size_t)((sumbase + chunk) * 2 + dir) * 512 + cg) * 2) = (f32x2){ap, h};
        } else {
            float h = S == 256 ? 0.f : F.p->state[(((size_t)(seq - 16) * 4 + l) * 2 + dir) * 512 + cg];
            const int cnt = dir ? nch - 1 - chunk : chunk;
            for (int j0 = 0; j0 < cnt; j0 += 8) { f32x2 v[8];
#pragma unroll
                for (int u = 0; u < 8; ++u) { const int j = j0 + u; const int cj = dir ? nch - 1 - j : j; v[u] = (j < cnt) ? *(const f32x2*)(sum + ((size_t)((sumbase + cj) * 2 + dir) * 512 + cg) * 2) : (f32x2){1.f, 0.f}; }
#pragma unroll
                for (int u = 0; u < 8; ++u) h = v[u].x * h + v[u].y; }
            for (int s = 0; s < 64; ++s) { const int t = dir ? 63 - s : s; h = Abuf[(dir * 64 + t) * 128 + c] * h + Bbuf[(dir * 64 + t) * 128 + c]; Bbuf[(dir * 64 + t) * 128 + c] = h; }
            if (S == 256 && ((dir == 0 && chunk == nch - 1) || (dir == 1 && chunk == 0))) F.p->out[O_ST + (((size_t)seq * 4 + l) * 2 + dir) * 512 + cg] = h;
        }
    }
    __syncthreads();
    if (PASS == 2) {
        bf16* mix = (bf16*)(F.ws + WS_MIX);
        for (int idx = tid; idx < 64 * 64; idx += NTHR) { const int tok = idx >> 6, c2 = (idx & 63) * 2; const size_t row = (size_t)row0 + t0 + tok;
            const f32x2 g = *(const f32x2*)(bxg + row * 1024 + 512 + n * 128 + c2);
            const float y0 = (Bbuf[tok * 128 + c2] + Bbuf[(64 + tok) * 128 + c2]) * gelu_tanh(g.x), y1 = (Bbuf[tok * 128 + c2 + 1] + Bbuf[(64 + tok) * 128 + c2 + 1]) * gelu_tanh(g.y);
            *(unsigned*)(mix + row * DM + 512 + n * 128 + c2) = pk2(y0, y1); }
        __syncthreads();
    }
}

__device__ __forceinline__ void ph_mix(Frame& F, int l) {
    LAS char* lds = (LAS char*)F.lds;
    unsigned char* ws = F.ws;
    float lam, lam_init;
    { const float* lw = F.p->lam_w + (size_t)l * 256; float s1 = 0.f, s2 = 0.f;
      for (int i = 0; i < 64; ++i) { s1 += lw[i] * lw[64 + i]; s2 += lw[128 + i] * lw[192 + i]; }
      lam_init = 0.8f - 0.6f * expf(-0.3f * (float)l); lam = expf(s1) - expf(s2) + lam_init; }
    float* park = (float*)(ws + WS_PARK) + (size_t)F.wg * 64 * 512;
#ifndef MK_MIXMASK
#define MK_MIXMASK 7
#endif
    fresh(F);
    if (MK_MIXMASK & 1) for (int u = F.wg; u < 768; u += F.G) {
        const bool alat = u < 128, actx = (u >= 256 && u < 320);
        if (!(alat || actx)) continue;
        AttnDesc a; a.na = 0; a.r0 = 0; a.kr_lo = 0; a.ldq = 512; a.ldk = 512; a.ldo = DM; a.park = park; a.lam = lam; a.oscale = 1.f - lam_init; a.base1 = 0;
        int h; size_t qrow;
        if (alat) { const int xcd = u & 7, k = u >> 3, combo = xcd + 8 * (k >> 3), qb = k & 7, b = combo >> 2; h = combo & 3; qrow = (size_t)NCTX + b * 2048 + qb * 256;
            a.K = (const bf16*)(ws + WS_KA_LAT) + (size_t)b * 2560 * 512 + h * 128; a.V = (const bf16*)(ws + WS_VA_LAT) + (size_t)b * 2560 * 512 + h * 128; a.nt = 40; a.nt0 = 40; }
        else { const int v = u - 256, b = v >> 2; h = v & 3; qrow = (size_t)b * 256;
            a.K = (const bf16*)(ws + WS_KA_CTX) + (size_t)b * 256 * 512 + h * 128; a.V = (const bf16*)(ws + WS_VA_CTX) + (size_t)b * 256 * 512 + h * 128; a.nt = 4; a.nt0 = 4; }
        a.O = (bf16*)(ws + WS_MIX) + qrow * DM + h * 128;
        for (int c = 0; c < 2; ++c) { a.Q = (const bf16*)(ws + WS_QA) + qrow * 512 + h * 128 + c * 64; a.kd0 = 4 * c; a.omode = c + 1; attn_body<4, 0, 512>(a, lds); }
    }
    if (MK_MIXMASK & 2) for (int u = F.wg; u < 768; u += F.G) {
        const bool dlat = (u >= 128 && u < 256), cctx = (u >= 320 && u < 384), nau = (u >= 384 && u < 512), dctx = (u >= 640 && u < 704);
        if (!(dlat || cctx || nau || dctx)) continue;
        AttnDesc a; a.na = 0; a.r0 = 0; a.kr_lo = 0; a.ldq = 512; a.ldk = 512; a.ldo = DM; a.park = park; a.lam = 0.f; a.oscale = 1.f; a.base1 = 0; a.kd0 = 0; a.omode = 0;
        if (dlat) { const int v = u - 128, xcd = v & 7, k = v >> 3, combo = xcd + 8 * (k >> 3), qb = k & 7, b = combo >> 2, hq = combo & 3, kvh = hq >> 1; const size_t qrow = (size_t)NCTX + b * 2048 + qb * 256;
            a.Q = (const bf16*)(ws + WS_QD) + qrow * 512 + hq * 128; a.ldk = 256; a.K = (const bf16*)(ws + WS_KD_LAT) + (size_t)b * 2560 * 256 + kvh * 128; a.V = (const bf16*)(ws + WS_VD_LAT) + (size_t)b * 2560 * 256 + kvh * 128;
            a.nt = 40; a.nt0 = 40; a.O = (bf16*)(ws + WS_MIX) + qrow * DM + 1536 + hq * 128; }
        else if (dctx) { const int v = u - 640, b = v >> 2, hq = v & 3, kvh = hq >> 1; const size_t qrow = (size_t)b * 256;
            a.Q = (const bf16*)(ws + WS_QD) + qrow * 512 + hq * 128; a.ldk = 256; a.K = (const bf16*)(ws + WS_KD_CTX) + (size_t)b * 256 * 256 + kvh * 128; a.V = (const bf16*)(ws + WS_VD_CTX) + (size_t)b * 256 * 256 + kvh * 128;
            a.nt = 4; a.nt0 = 4; a.O = (bf16*)(ws + WS_MIX) + qrow * DM + 1536 + hq * 128; }
        else if (cctx) { const int v = u - 320, b = v >> 2, h = v & 3; const size_t qrow = (size_t)b * 256;
            a.Q = (const bf16*)(ws + WS_QC) + qrow * 512 + h * 128; a.K = (const bf16*)(ws + WS_KC_CTX) + (size_t)b * 256 * 512 + h * 128; a.V = (const bf16*)(ws + WS_VC_CTX) + (size_t)b * 256 * 512 + h * 128;
            a.nt = 4; a.nt0 = 4; a.O = (bf16*)(ws + WS_MIX) + qrow * DM + 1024 + h * 128; }
        else { const int v = u - 384, xcd = v & 7, k = v >> 3, combo = xcd + 8 * (k >> 3), qb = k & 7, b = combo >> 2, h = combo & 3; const size_t qrow = (size_t)NCTX + b * 2048 + qb * 256;
            const int r0 = qb * 4; int lo = r0 - 4; lo = lo < 0 ? 0 : lo; int hi_ = r0 + 8; hi_ = hi_ > 32 ? 32 : hi_; if (hi_ - lo < 8) lo = hi_ - 8; int nloc = hi_ - lo; if (nloc & 1) { if (lo > 0) --lo; else ++hi_; nloc = hi_ - lo; }
            a.Q = (const bf16*)(ws + WS_QC) + qrow * 512 + h * 128; a.K = (const bf16*)(ws + WS_KC_LAT) + (size_t)b * 2560 * 512 + h * 128; a.V = (const bf16*)(ws + WS_VC_LAT) + (size_t)b * 2560 * 512 + h * 128;
            a.na = 1; a.r0 = r0; a.kr_lo = lo; a.nt0 = 8; a.nt = 8 + nloc; a.base1 = 512 + 64 * lo; a.O = (bf16*)(ws + WS_MIX) + qrow * DM + 1024 + h * 128;
            LAS float* tab = (LAS float*)(lds + ATT_TAB_OFF); const float* rp = F.p->rpb + ((size_t)l * 4 + h) * 15 * 31;
            int ti = threadIdx.x; asm volatile("" : "+v"(ti));
            for (int i = ti; i < 15 * 32; i += NTHR) { const int dr = i >> 5, dc = i & 31; tab[i] = dc < 31 ? rp[dr * 31 + dc] * 11.313708498984761f : 0.f; } }
        if (a.na) attn_body<8, 1, 512>(a, lds); else if (a.ldk == 256) attn_body<8, 0, 256>(a, lds); else attn_body<8, 0, 512>(a, lds);
    }
    if (MK_MIXMASK & 4) for (int u = F.wg; u < 768; u += F.G) lru_unit<2>(F, l, u);
}
}
namespace mk {
#define XB_TMO      128
#define XB_XCNT(j)  (256  + 64 * (j))
#define XB_XSUB(j)  (1280 + 64 * (j))
#define XB_XGEN(j)  (2304 + 64 * (j))
#define XB_TOP      3328
#define XB_TOPGEN   3392
#define XCD_BAR_WORDS 3456
#define XB_SPIN_CAP (1u << 18)
__device__ __forceinline__ unsigned xb_ld(unsigned* p)              { return __hip_atomic_load(p, __ATOMIC_RELAXED, __HIP_MEMORY_SCOPE_AGENT); }
__device__ __forceinline__ unsigned xb_add(unsigned* p, unsigned v) { return __hip_atomic_fetch_add(p, v, __ATOMIC_RELAXED, __HIP_MEMORY_SCOPE_AGENT); }
__device__ __forceinline__ unsigned xb_xcc_id() { return (unsigned)__builtin_amdgcn_s_getreg((3 << 11) | 20) & 0xFu; }
#define XB_SPIN(cond, bar) do { unsigned _sp = 0; while (cond) { __builtin_amdgcn_s_sleep(1); \
    if ((++_sp & 255u) == 0u) { if (xb_ld(&(bar)[XB_TMO])) break; if (_sp > XB_SPIN_CAP) { atomicAdd(&(bar)[XB_TMO], 1u); break; } } } } while (0)
struct XcdBarrier { unsigned* bar; unsigned x; volatile LAS unsigned* st; };
__device__ __forceinline__ XcdBarrier xcd_barrier_post(unsigned* bar, volatile LAS unsigned* st) {
    XcdBarrier b; b.bar = bar; b.x = xb_xcc_id(); b.st = st;
    if (threadIdx.x == 0) (void)xb_add(&bar[XB_XCNT(b.x)], 1u);
    return b;
}
__device__ __forceinline__ void xcd_barrier_complete(unsigned* bar, unsigned x, unsigned& nloc, unsigned& nx) {
    const unsigned G = gridDim.x * gridDim.y * gridDim.z;
    unsigned sum, cnt, mine, sp = 0u;
    for (;;) {
        sum = 0u; cnt = 0u; mine = 0u;
#pragma unroll
        for (unsigned j = 0; j < 16; ++j) { const unsigned c = xb_ld(&bar[XB_XCNT(j)]); sum += c; cnt += (c > 0u) ? 1u : 0u; mine = (j == x) ? c : mine; }
        if (sum == G) break;
        __builtin_amdgcn_s_sleep(1);
        if ((++sp & 255u) == 0u) { if (xb_ld(&bar[XB_TMO])) break; if (sp > XB_SPIN_CAP) { atomicAdd(&bar[XB_TMO], 1u); break; } }
    }
    nloc = mine > 0u ? mine : 1u; nx = cnt > 0u ? cnt : 1u;
}
__device__ __forceinline__ void xcd_barrier(const XcdBarrier& b) {
    asm volatile("s_waitcnt vmcnt(0)" ::: "memory");
    __syncthreads();
    if (threadIdx.x == 0) {
        unsigned* bar = b.bar;
        __builtin_amdgcn_s_waitcnt(0);
        unsigned nloc = b.st[0], nx = b.st[1];
        if (nloc == 0u) { xcd_barrier_complete(bar, b.x, nloc, nx); b.st[0] = nloc; b.st[1] = nx; }
        const unsigned old = xb_add(&bar[XB_XSUB(b.x)], 1u);
        const unsigned gen = old / nloc;
        if (old + 1u == (gen + 1u) * nloc) {
            __builtin_amdgcn_fence(__ATOMIC_RELEASE, "agent");
            asm volatile("s_waitcnt vmcnt(0)" ::: "memory");
            const unsigned og = xb_add(&bar[XB_TOP], 1u);
            const unsigned tg = og / nx;
            if (og + 1u == (tg + 1u) * nx) xb_add(&bar[XB_TOPGEN], 1u);
            else XB_SPIN(xb_ld(&bar[XB_TOPGEN]) == tg, bar);
            __builtin_amdgcn_fence(__ATOMIC_ACQUIRE, "agent");
            xb_add(&bar[XB_XGEN(b.x)], 1u);
            asm volatile("s_waitcnt vmcnt(0)" ::: "memory");
        } else {
            XB_SPIN(xb_ld(&bar[XB_XGEN(b.x)]) == gen, bar);
            __builtin_amdgcn_fence(__ATOMIC_ACQUIRE, "agent");
            asm volatile("s_waitcnt vmcnt(0)" ::: "memory");
        }
    }
    __syncthreads();
}

constexpr int N_PHASES = 2 + 8 * DEPTH;
__global__ void __launch_bounds__(NTHR, 2) mk_fwd(Params p) {
    extern __shared__ __attribute__((aligned(16))) unsigned char lds_raw[];
    Frame F;
    F.lds = (LAS unsigned char*)lds_raw;
    F.tid = threadIdx.x; F.lane = F.tid & 63; F.wave = __builtin_amdgcn_readfirstlane(F.tid >> 6);
    F.G = gridDim.x; F.wg = blockIdx.x; fresh(F);
    volatile LAS unsigned* MISC = (volatile LAS unsigned*)(F.lds + MISC_OFF);
    for (int u = F.tid; u < (LDS_BYTES - LDSCTL_OFF) / 4; u += NTHR) ((LAS unsigned*)(F.lds + LDSCTL_OFF))[u] = 0u;
    __syncthreads();
    const int lo = p.ph_lo, hi = p.ph_hi;
    const bool multi = (hi - lo) > 1;
    XcdBarrier bar; bar.bar = (unsigned*)(p.ws + WS_CTL) + CW_BAR; bar.x = 0; bar.st = nullptr;
    if (multi) bar = xcd_barrier_post((unsigned*)(p.ws + WS_CTL) + CW_BAR, MISC + 8);
#define IN(k) (lo <= (k) && (k) < hi)
#define SEAM(k) do { if (IN(k) && IN((k) + 1)) xcd_barrier(bar); } while (0)
#ifndef MK_MASK
#define MK_MASK 0x3ff
#endif
#define ON(b) ((MK_MASK >> (b)) & 1)
    if (ON(0) && IN(0)) { fresh(F); ph_prologue(F); } SEAM(0);
    if (ON(1) && IN(1)) { ph_norm0(F); } SEAM(1);
    for (int l = 0; l < DEPTH; ++l) {
        const int pb = 2 + 8 * l;
        if (ON(2) && IN(pb + 0)) { fresh(F); pg8::Gemm g{(const bf16*)(F.ws + WS_H), (const bf16*)(F.ws + WS_WIN) + (size_t)l * INW * DM, NTOK, INW, DM}; pg8::StaticOrder S; S.init(NTOK, INW, F.G, F.wg);
            EpiIn E{F.ws, F.p->out, l}; pg8::gemm_phase<EpiIn, pg8::StaticOrder, true, true>(F.lds, g, S, E); }
        SEAM(pb + 0);
        if (ON(3) && IN(pb + 1)) { fresh(F); for (int u = F.wg; u < 768; u += F.G) lru_unit<1>(F, l, u); ph_prep_items(F, l); }
        SEAM(pb + 1);
        if (ON(4) && IN(pb + 2)) { fresh(F); ph_mix(F, l); }
        SEAM(pb + 2);
        if (ON(5) && IN(pb + 3)) { fresh(F); pg8::Gemm g{(const bf16*)(F.ws + WS_MIX), (const bf16*)(F.ws + WS_WOUT) + (size_t)l * DM * DM, NTOK, DM, DM}; pg8::StaticOrder S; S.init(NTOK, DM, F.G, F.wg);
            EpiF32 E{(float*)(F.ws + WS_Y), DM}; pg8::gemm_phase<EpiF32, pg8::StaticOrder, true, true>(F.lds, g, S, E); }
        SEAM(pb + 3);
        if (ON(6) && IN(pb + 4)) { ph_norm(F, l, 2, true, l, 3); }
        SEAM(pb + 4);
        if (ON(7) && IN(pb + 5)) { fresh(F); pg8::Gemm g{(const bf16*)(F.ws + WS_H), (const bf16*)(F.ws + WS_WF1) + (size_t)l * FF2 * DM, NTOK, FF2, DM}; pg8::StaticOrder S; S.init(NTOK, FF2, F.G, F.wg);
            EpiSwiglu E{(bf16*)(F.ws + WS_T)}; pg8::gemm_phase<EpiSwiglu, pg8::StaticOrder, true, true>(F.lds, g, S, E); }
        SEAM(pb + 5);
        if (ON(8) && IN(pb + 6)) { fresh(F); pg8::Gemm g{(const bf16*)(F.ws + WS_T), (const bf16*)(F.ws + WS_WF2) + (size_t)l * DM * FFH, NTOK, DM, FFH}; pg8::StaticOrder S; S.init(NTOK, DM, F.G, F.wg);
            EpiF32 E{(float*)(F.ws + WS_Y), DM}; pg8::gemm_phase<EpiF32, pg8::StaticOrder, true, true>(F.lds, g, S, E); }
        SEAM(pb + 6);
        if (ON(9) && IN(pb + 7)) { ph_norm(F, l, 5, l + 1 < DEPTH, l + 1 < DEPTH ? l + 1 : l, 0); }
        SEAM(pb + 7);
    }
#undef IN
#undef SEAM
}

static int g_grid = 0;
static bool setup() {
    if (g_grid) return g_grid > 0;
    int dev = 0, cus = 0;
    if (hipGetDevice(&dev) != hipSuccess || hipDeviceGetAttribute(&cus, hipDeviceAttributeMultiprocessorCount, dev) != hipSuccess) { g_grid = -1; return false; }
    if (hipFuncSetAttribute((const void*)mk_fwd, hipFuncAttributeMaxDynamicSharedMemorySize, LDS_BYTES) != hipSuccess) { fprintf(stderr, "hipFuncSetAttribute failed\n"); g_grid = -1; return false; }
    int per_cu = 0;
    if (hipOccupancyMaxActiveBlocksPerMultiprocessor(&per_cu, (const void*)mk_fwd, NTHR, LDS_BYTES) != hipSuccess || per_cu < 1) fprintf(stderr, "occupancy query: %d\n", per_cu);
    (void)hipGetLastError();
    g_grid = cus;
    return true;
}
static Params make_params(void* const* d_in, void* d_out, unsigned char* ws) {
    Params p{}; const float** q = (const float**)&p; for (int i = 0; i < 23; ++i) q[i] = (const float*)d_in[i];
    p.out = (float*)d_out; p.ws = ws; p.ph_lo = 0; p.ph_hi = N_PHASES; return p;
}
static void launch_phases(const Params& base, int lo, int hi, hipStream_t st) {
    Params p = base; p.ph_lo = lo; p.ph_hi = hi;
    hipLaunchKernelGGL(mk_fwd, dim3(g_grid), dim3(NTHR), LDS_BYTES, st, p);
}
}
extern "C" void kernel_launch(void* const* d_in, const int* in_sizes, int n_in,
                              void* d_out, int out_size, void* d_ws, size_t ws_size,
                              hipStream_t stream) {
    if (!mk::setup()) return;
    (void)hipMemsetAsync((char*)d_ws + mk::WS_CTL, 0, mk::CTL_ZERO_BYTES, stream);
    mk::Params p = mk::make_params(d_in, d_out, (unsigned char*)d_ws);
    mk::launch_phases(p, 0, mk::N_PHASES, stream);
}
```
